# Optimizing an MI355X kernel written in HIP

```python
import jax, jax.numpy as jnp
from jax import lax
import numpy as np

D_MODEL = 1024
BATCH = 8
SEQ = 8192
DEPTH = 1
DEC_BATCH = 8
DEC_SEQ = 16
PAST_LEN = 2048

CHUNK = 64
QBLK = 128
H_A = 8
DH_A = 64
FOX_W = H_A * DH_A
H_B = 4
DK_B = 128
DV_B = 256
GLA_K = H_B * DK_B
GLA_V = H_B * DV_B
GLA_RANK = 16
GLA_TAU = 16
D_FF = 2816
CONV_W = 3
PLE_DIM = 256
LN_EPS = 1e-5
ALPHA = (2 * DEPTH) ** 0.25
BETA = (8 * DEPTH) ** -0.25
IN_SIZES = (FOX_W, FOX_W, FOX_W, H_A, GLA_K, GLA_K, GLA_V, GLA_V, GLA_RANK, D_MODEL, D_MODEL)
D_IN = FOX_W * 3 + H_A + GLA_K * 2 + GLA_V * 2 + GLA_RANK + D_MODEL * 2

kernel_name = "fox_gla_convffn_deepnorm_stream_step"


def _split_points():
    pts, acc = [], 0
    for s in IN_SIZES[:-1]:
        acc += s
        pts.append(acc)
    return pts


def layer_norm(x, g, b):
    xf = x.astype(jnp.float32)
    mu = jnp.mean(xf, axis=-1, keepdims=True)
    var = jnp.mean(jnp.square(xf - mu), axis=-1, keepdims=True)
    y = (xf - mu) * lax.rsqrt(var + LN_EPS) * g.astype(jnp.float32) + b.astype(jnp.float32)
    return y.astype(x.dtype)


def fox_attend(q, k, v, cq, ck, q_pos, k_pos):
    s = jnp.einsum('bqhd,bkhd->bhqk', q, k).astype(jnp.float32) * (DH_A ** -0.5)
    s = s + jnp.transpose(cq, (0, 2, 1))[..., :, None] - jnp.transpose(ck, (0, 2, 1))[..., None, :]
    mask = k_pos[None, :] <= q_pos[:, None]
    s = jnp.where(mask, s, -jnp.inf)
    p = jax.nn.softmax(s, axis=-1)
    return jnp.einsum('bhqk,bkhd->bqhd', p.astype(v.dtype), v)


def fox_mixer(q, k, v, logf, past):
    T = q.shape[1]
    if past is None:
        c = jnp.cumsum(logf, axis=1)
        outs = []
        for i in range(T // QBLK):
            lo, hi = i * QBLK, (i + 1) * QBLK
            outs.append(fox_attend(q[:, lo:hi], k[:, :hi], v[:, :hi], c[:, lo:hi], c[:, :hi],
                                   jnp.arange(lo, hi), jnp.arange(hi)))
        return jnp.concatenate(outs, axis=1)
    past_k, past_v, past_logf = past
    P = past_k.shape[1]
    k_all = jnp.concatenate([past_k.astype(k.dtype), k], axis=1)
    v_all = jnp.concatenate([past_v.astype(v.dtype), v], axis=1)
    c = jnp.cumsum(jnp.concatenate([past_logf.astype(jnp.float32), logf], axis=1), axis=1)
    return fox_attend(q, k_all, v_all, c[:, P:], c, P + jnp.arange(T), jnp.arange(P + T))


def gla_block(S, inp):
    q, k, v, la = inp
    L = q.shape[2]
    b = jnp.cumsum(la, axis=2)
    tri = jnp.tril(jnp.ones((L, L), dtype=bool))
    diff = b[:, :, :, None, :] - b[:, :, None, :, :]
    decay = jnp.exp(jnp.where(tri[:, :, None], diff, -jnp.inf))
    a = jnp.einsum('bhtc,bhtsc,bhsc->bhts', q, decay, k)
    o = jnp.einsum('bhts,bhsv->bhtv', a, v) + jnp.einsum('bhtc,bhcv->bhtv', q * jnp.exp(b), S)
    b_last = b[:, :, -1:, :]
    S_new = jnp.exp(b_last[:, :, 0, :])[..., None] * S + jnp.einsum('bhsc,bhsv->bhcv', k * jnp.exp(b_last - b), v)
    return S_new, o


def gla_mixer(q, k, v, la, S0):
    B, T, H, _ = q.shape
    L = min(CHUNK, T)
    n = T // L

    def to_blocks(a):
        return a.astype(jnp.float32).reshape(B, n, L, H, a.shape[-1]).transpose(1, 0, 3, 2, 4)

    S_fin, o = lax.scan(gla_block, S0.astype(jnp.float32), (to_blocks(q), to_blocks(k), to_blocks(v), to_blocks(la)))
    o = o.transpose(1, 0, 3, 2, 4).reshape(B, T, H, v.shape[-1])
    return o, S_fin


def trunk_layer(x, p, fox_past, gla_S0, conv_prev,
                w_in, b_fgate, w_a2, b_a2, g_gla, w_a_out, w_b_out, w_o, ln1_g, ln1_b,
                w_up, conv_w, conv_b, w_down, ln2_g, ln2_b, w_pl, w_plg, ln3_g, ln3_b):
    B, T, _ = x.shape
    proj = x @ w_in
    qa, ka, va, fa, qb, kb, vb, rb, a1, ga, gb = jnp.split(proj, _split_points(), axis=-1)

    qa = qa.reshape(B, T, H_A, DH_A)
    ka = ka.reshape(B, T, H_A, DH_A)
    va = va.reshape(B, T, H_A, DH_A)
    logf = jax.nn.log_sigmoid((fa + b_fgate).astype(jnp.float32))
    oa = fox_mixer(qa, ka, va, logf, fox_past)
    ya = oa.reshape(B, T, FOX_W) @ w_a_out

    la = jax.nn.log_sigmoid((a1 @ w_a2 + b_a2).astype(jnp.float32)) / GLA_TAU
    ob, S_fin = gla_mixer(qb.reshape(B, T, H_B, DK_B) * (DK_B ** -0.5), kb.reshape(B, T, H_B, DK_B),
                          vb.reshape(B, T, H_B, DV_B), la.reshape(B, T, H_B, DK_B), gla_S0)
    ob = ob * lax.rsqrt(jnp.mean(jnp.square(ob), axis=-1, keepdims=True) + LN_EPS) \
        * g_gla.astype(jnp.float32).reshape(H_B, DV_B)
    yb = (ob.astype(x.dtype) * jax.nn.silu(rb.reshape(B, T, H_B, DV_B))).reshape(B, T, GLA_V) @ w_b_out

    merged = jax.nn.sigmoid(ga) * ya + jax.nn.sigmoid(gb) * yb
    x1 = layer_norm(ALPHA * x + merged @ w_o, ln1_g, ln1_b)

    up = x1 @ w_up
    ext = jnp.concatenate([conv_prev.astype(up.dtype), up], axis=1)
    conv = conv_b + sum(conv_w[j] * ext[:, j:j + T] for j in range(CONV_W))
    conv_new = ext[:, T:]
    val, gate = jnp.split(conv, 2, axis=-1)
    ffn = (val * jax.nn.gelu(gate)) @ w_down
    x2 = layer_norm(ALPHA * x1 + ffn, ln2_g, ln2_b)

    e = (p @ w_pl) * jax.nn.sigmoid(x2 @ w_plg)
    y = layer_norm(ALPHA * x2 + e, ln3_g, ln3_b)
    return y, ka, va, logf.astype(x.dtype), S_fin.astype(x.dtype), conv_new


def setup_inputs(seed: int = 0) -> dict:
    key = jax.random.key(seed)
    ks = jax.random.split(key, 32)

    def nrm(k, shape, scale):
        return jax.random.normal(k, shape, jnp.float32) * scale

    D = D_MODEL
    return {
        "x_prompt": nrm(ks[0], (BATCH, SEQ, D), 1.0),
        "x_sample": nrm(ks[1], (DEC_BATCH, DEC_SEQ, D), 1.0),
        "cache_fox_k": nrm(ks[2], (DEPTH, DEC_BATCH, PAST_LEN, H_A, DH_A), 1.0),
        "cache_fox_v": nrm(ks[3], (DEPTH, DEC_BATCH, PAST_LEN, H_A, DH_A), 1.0),
        "cache_fox_logf": jax.nn.log_sigmoid(nrm(ks[4], (DEPTH, DEC_BATCH, PAST_LEN, H_A), 1.0) + 3.0),
        "state_gla": nrm(ks[5], (DEPTH, DEC_BATCH, H_B, DK_B, DV_B), 0.1),
        "cache_ffn_conv": nrm(ks[6], (DEPTH, DEC_BATCH, CONV_W - 1, 2 * D_FF), 1.0),
        "p_prompt": nrm(ks[7], (DEPTH, BATCH, SEQ, PLE_DIM), 1.0),
        "p_sample": nrm(ks[8], (DEPTH, DEC_BATCH, DEC_SEQ, PLE_DIM), 1.0),
        "w_in": nrm(ks[9], (DEPTH, D, D_IN), D ** -0.5),
        "b_fgate": jax.random.uniform(ks[10], (DEPTH, H_A), jnp.float32, 1.0, 4.0),
        "w_a2": nrm(ks[11], (DEPTH, GLA_RANK, GLA_K), GLA_RANK ** -0.5),
        "b_a2": nrm(ks[12], (DEPTH, GLA_K), 0.1),
        "g_gla": 1.0 + nrm(ks[13], (DEPTH, GLA_V), 0.05),
        "w_a_out": nrm(ks[14], (DEPTH, FOX_W, D), FOX_W ** -0.5),
        "w_b_out": nrm(ks[15], (DEPTH, GLA_V, D), GLA_V ** -0.5),
        "w_o": nrm(ks[16], (DEPTH, D, D), D ** -0.5 * BETA),
        "ln1_g": 1.0 + nrm(ks[17], (DEPTH, D), 0.05),
        "ln1_b": nrm(ks[18], (DEPTH, D), 0.02),
        "w_up": nrm(ks[19], (DEPTH, D, 2 * D_FF), D ** -0.5),
        "conv_w": nrm(ks[20], (DEPTH, CONV_W, 2 * D_FF), CONV_W ** -0.5),
        "conv_b": nrm(ks[21], (DEPTH, 2 * D_FF), 0.02),
        "w_down": nrm(ks[22], (DEPTH, D_FF, D), D_FF ** -0.5 * BETA),
        "ln2_g": 1.0 + nrm(ks[23], (DEPTH, D), 0.05),
        "ln2_b": nrm(ks[24], (DEPTH, D), 0.02),
        "w_pl": nrm(ks[25], (DEPTH, PLE_DIM, D), PLE_DIM ** -0.5 * BETA),
        "w_plg": nrm(ks[26], (DEPTH, D, D), D ** -0.5),
        "ln3_g": 1.0 + nrm(ks[27], (DEPTH, D), 0.05),
        "ln3_b": nrm(ks[28], (DEPTH, D), 0.02),
    }


def reference(x_prompt, x_sample, cache_fox_k, cache_fox_v, cache_fox_logf, state_gla, cache_ffn_conv,
              p_prompt, p_sample, w_in, b_fgate, w_a2, b_a2, g_gla, w_a_out, w_b_out, w_o, ln1_g, ln1_b,
              w_up, conv_w, conv_b, w_down, ln2_g, ln2_b, w_pl, w_plg, ln3_g, ln3_b):
    hp, hs = x_prompt, x_sample
    kp_l, vp_l, fp_l, sp_l, cp_l = [], [], [], [], []
    ks_l, vs_l, fs_l, ss_l, cs_l = [], [], [], [], []
    for i in range(DEPTH):
        lp = (w_in[i], b_fgate[i], w_a2[i], b_a2[i], g_gla[i], w_a_out[i], w_b_out[i], w_o[i],
              ln1_g[i], ln1_b[i], w_up[i], conv_w[i], conv_b[i], w_down[i], ln2_g[i], ln2_b[i],
              w_pl[i], w_plg[i], ln3_g[i], ln3_b[i])
        S0_p = jnp.zeros((hp.shape[0], H_B, DK_B, DV_B), jnp.float32)
        conv0_p = jnp.zeros((hp.shape[0], CONV_W - 1, 2 * D_FF), hp.dtype)
        hp, kp, vp, fp, sp, cp = trunk_layer(hp, p_prompt[i], None, S0_p, conv0_p, *lp)
        hs, k_s, v_s, f_s, s_s, c_s = trunk_layer(
            hs, p_sample[i], (cache_fox_k[i], cache_fox_v[i], cache_fox_logf[i]),
            state_gla[i], cache_ffn_conv[i], *lp)
        kp_l.append(kp); vp_l.append(vp); fp_l.append(fp); sp_l.append(sp); cp_l.append(cp)
        ks_l.append(k_s); vs_l.append(v_s); fs_l.append(f_s); ss_l.append(s_s); cs_l.append(c_s)
    return (hp, hs,
            jnp.stack(kp_l), jnp.stack(vp_l), jnp.stack(fp_l), jnp.stack(sp_l), jnp.stack(cp_l),
            jnp.stack(ks_l), jnp.stack(vs_l), jnp.stack(fs_l), jnp.stack(ss_l), jnp.stack(cs_l))
```

```cpp
#include <hip/hip_runtime.h>
#include <hip/hip_cooperative_groups.h>
#include <hip/hip_bf16.h>
#include <cstdio>
#include <cstdint>
#include <cmath>
#ifndef ONE_LAUNCH
#define ONE_LAUNCH 1
#endif
constexpr int DM_ = 1024, TSEQ = 8192, MP = 65536, MROWS = 65664, MPAD = 65792;
constexpr int DFF = 2816;
constexpr float LN_EPS = 1e-5f;
constexpr float ALPHA = 1.189207115002721f;
constexpr size_t O_Y = 0, O_KP = 67239936, O_VP = 100794368, O_FP = 134348800, O_SP = 134873088, O_CP = 135921664,
                 O_KS = 136011776, O_VS = 136077312, O_FS = 136142848, O_SS = 136143872, O_CS = 137192448;
__device__ __forceinline__ int lane_id_asm() { int l; asm volatile("v_mbcnt_lo_u32_b32 %0, -1, 0\n\tv_mbcnt_hi_u32_b32 %0, -1, %0" : "=v"(l)); return l; }
#define TIDX(wv) ((wv) * 64 + lane_id_asm())
namespace pg8 {
#define PG8_LAS __attribute__((address_space(3)))
typedef unsigned short bf16_t;
typedef short bf16x8 __attribute__((ext_vector_type(8)));
typedef float f32x4 __attribute__((ext_vector_type(4)));
typedef unsigned u32x4 __attribute__((ext_vector_type(4)));
constexpr int BM = 256, BK = 64, HALF = 128, HTB = HALF * BK * 2  , STAGE_BYTES = 8 * HTB, NXCD = 8, WGM = 8;

__host__ __device__ __forceinline__ int lds_byte(int r, int c) { const int st = (r >> 4) * 2 + (c >> 5), rr = r & 15, cc = c & 31, ob = rr * 64 + cc * 2; return st * 1024 + (ob ^ (((ob >> 9) & 1) << 5)); }
__host__ __device__ __forceinline__ void stage_rc(int b, int& R, int& C) { const int st = b / 1024, sb = b % 1024, swz = sb ^ (((sb >> 9) & 1) << 5); R = (st >> 1) * 16 + swz / 64; C = (st & 1) * 32 + (swz % 64) / 2; }
__host__ __device__ __forceinline__ int perm32(int rho) { const int n = rho >> 4, i = rho & 15; return 8 * (i >> 2) + 4 * n + (i & 3); }

struct Unit { int pm, pn; };
struct Gemm { const bf16_t* A; const bf16_t* Bt; int M, N, K; };

struct StaticOrder {
    int nM, nN, nwg, G, c;
    __host__ __device__ void init(int M, int N, int G_, int c_) { nM = M / BM; nN = N / BM; nwg = nM * nN; G = G_; c = c_; }
    __host__ __device__ bool next(int i, Unit& u) const {
        const long L = (long)i * G + c; if (L >= nwg) return false;
        int wgid = (int)L; { const int q = nwg / NXCD, r = nwg % NXCD, xcd = wgid % NXCD, off = wgid / NXCD; wgid = (xcd < r ? xcd * (q + 1) : r * (q + 1) + (xcd - r) * q) + off; }
        const int nig = WGM * nN, gid = wgid / nig, fm = gid * WGM, gsz = (nM - fm) < WGM ? (nM - fm) : WGM;
        u.pm = fm + ((wgid % nig) % gsz); u.pn = (wgid % nig) / gsz; return true;
    }
    __device__ __forceinline__ void a_ready(const Unit&) const {}
    __device__ __forceinline__ void done(const Unit&) const {}
};

__device__ __forceinline__ unsigned cvt_pk_bf16(float lo, float hi) { unsigned r; asm volatile("v_cvt_pk_bf16_f32 %0, %1, %2" : "=v"(r) : "v"(lo), "v"(hi)); return r; }
template <class Epi, class Sched, bool ALIGN_EPI = false, bool SP2 = false>
__device__ __forceinline__ void gemm_phase(PG8_LAS unsigned char* lds, const Gemm g, const Sched& S, const Epi& E, const int wv) {
    const int tid = TIDX(wv), wid = wv, lane = tid & 63, wr = wid >> 2, wc = wid & 3, fr = lane & 15, fq = lane >> 4;
    const int K = g.K, nt = K / BK;
    unsigned voffA[2], voffB[2];
#pragma unroll
    for (int i = 0; i < 2; ++i) { int R, C; stage_rc(tid * 16 + i * 8192, R, C); const int Rb = Epi::PERM ? ((R & ~31) + perm32(R & 31)) : R;
        voffA[i] = (unsigned)(R * K + C) * 2u; voffB[i] = (unsigned)(Rb * K + C) * 2u; }
    const size_t kstep = (size_t)(BK * 2);
    const size_t hstep = (size_t)HALF * K * 2;
    const size_t tstep = 2 * hstep;
    const unsigned ldsw = (unsigned)wid * 1024u;
    const int aoff = lds_byte(wr * 64 + fr, fq * 8), boff = lds_byte(wc * 32 + fr, fq * 8);
#define PG8_SA(b, h) (((b) * 2 + (h)) * HTB)
#define PG8_SB(b, h) ((4 + (b) * 2 + (h)) * HTB)
#define PG8_STAGE(bufoff, gbase, voff) do { _Pragma("unroll") for (int _i = 0; _i < 2; ++_i) \
        __builtin_amdgcn_global_load_lds((const unsigned*)((const char*)(gbase) + (voff)[_i]), (PG8_LAS unsigned*)(lds + (bufoff) + ldsw + _i * 8192), 16, 0, 0); } while (0)
#define PG8_LDA(dst, b, h) do { _Pragma("unroll") for (int m = 0; m < 4; ++m) _Pragma("unroll") for (int k = 0; k < 2; ++k) dst[m][k] = *(const PG8_LAS bf16x8*)(lds + PG8_SA(b, h) + aoff + m * 2048 + k * 1024); } while (0)
#define PG8_LDB(dst, b, h) do { _Pragma("unroll") for (int n = 0; n < 2; ++n) _Pragma("unroll") for (int k = 0; k < 2; ++k) dst[n][k] = *(const PG8_LAS bf16x8*)(lds + PG8_SB(b, h) + boff + n * 2048 + k * 1024); } while (0)
#define PG8_MMA(ai, bj, At, Bt) do { __builtin_amdgcn_s_setprio(1); _Pragma("unroll") for (int m = 0; m < 4; ++m) _Pragma("unroll") for (int n = 0; n < 2; ++n) _Pragma("unroll") for (int k = 0; k < 2; ++k) \
        acc[ai][bj][m][n] = __builtin_amdgcn_mfma_f32_16x16x32_bf16(Bt[n][k], At[m][k], acc[ai][bj][m][n], 0, 0, 0); __builtin_amdgcn_s_setprio(0); } while (0)
#define PG8_WAIT_V(n) asm volatile("s_waitcnt vmcnt(" #n ")" ::: "memory")
#define PG8_WAIT_L(n) asm volatile("s_waitcnt lgkmcnt(" #n ")" ::: "memory")
#define PG8_BAR __builtin_amdgcn_s_barrier()
#define PG8_SCHED __builtin_amdgcn_sched_barrier(0)
    Unit cur, nxt; int ui = 0;
    if (!S.next(0, cur)) return;
    f32x4 acc[2][2][4][2];
#pragma unroll
    for (int a = 0; a < 2; ++a)
#pragma unroll
        for (int b = 0; b < 2; ++b)
#pragma unroll
            for (int m = 0; m < 4; ++m)
#pragma unroll
                for (int n = 0; n < 2; ++n) acc[a][b][m][n] = (f32x4){0.f, 0.f, 0.f, 0.f};
    bf16x8 At[4][2], B0[2][2], B1[2][2];
    const char* cA = (const char*)g.A + (size_t)cur.pm * tstep; const char* cB = (const char*)g.Bt + (size_t)cur.pn * tstep;
    S.a_ready(cur);
    if constexpr (SP2) {
        PG8_STAGE(PG8_SB(0, 0), cB, voffB); PG8_STAGE(PG8_SB(0, 1), cB + hstep, voffB); PG8_STAGE(PG8_SA(0, 0), cA, voffA); PG8_STAGE(PG8_SA(0, 1), cA + hstep, voffA);
        if (wr == 1) PG8_BAR;
        PG8_WAIT_V(2); PG8_BAR;
        PG8_STAGE(PG8_SB(1, 0), cB + kstep, voffB); PG8_STAGE(PG8_SA(1, 0), cA + kstep, voffA); PG8_STAGE(PG8_SB(1, 1), cB + hstep + kstep, voffB);
        PG8_WAIT_V(6); PG8_BAR;
    } else {
        PG8_STAGE(PG8_SB(0, 0), cB, voffB); PG8_STAGE(PG8_SA(0, 0), cA, voffA); PG8_STAGE(PG8_SB(0, 1), cB + hstep, voffB); PG8_STAGE(PG8_SA(0, 1), cA + hstep, voffA);
        if (wr == 1) PG8_BAR;
        PG8_WAIT_V(4); PG8_BAR;
        PG8_STAGE(PG8_SB(1, 0), cB + kstep, voffB); PG8_STAGE(PG8_SA(1, 0), cA + kstep, voffA); PG8_STAGE(PG8_SB(1, 1), cB + hstep + kstep, voffB);
        PG8_WAIT_V(6); PG8_BAR;
    }
    for (;;) {
        const bool has_next = S.next(ui + 1, nxt);
        const char* nA = has_next ? (const char*)g.A + (size_t)nxt.pm * tstep : cA; const char* nB = has_next ? (const char*)g.Bt + (size_t)nxt.pn * tstep : cB;
        for (int t = 0; t < nt; t += 2) {
            const bool last = (t == nt - 2);
            const char* a1 = cA + (size_t)(t + 1) * kstep;
            const char* a2 = last ? nA : cA + (size_t)(t + 2) * kstep; const char* b2 = last ? nB : cB + (size_t)(t + 2) * kstep;
            const char* a3 = a2 + kstep; const char* b3 = b2 + kstep;
            if (last && has_next) S.a_ready(nxt);
            if constexpr (SP2) {
            PG8_LDB(B0, 0, 0); PG8_LDB(B1, 0, 1); PG8_SCHED; PG8_LDA(At, 0, 0); PG8_STAGE(PG8_SA(1, 1), a1 + hstep, voffA);
            PG8_WAIT_V(8); PG8_WAIT_L(0); PG8_BAR; PG8_MMA(0, 0, At, B0); PG8_MMA(0, 1, At, B1); PG8_BAR; PG8_SCHED;
            PG8_LDA(At, 0, 1); PG8_STAGE(PG8_SB(0, 0), b2, voffB); PG8_STAGE(PG8_SB(0, 1), b2 + hstep, voffB); PG8_STAGE(PG8_SA(0, 0), a2, voffA);
            PG8_WAIT_V(8); PG8_WAIT_L(0); PG8_BAR; PG8_MMA(1, 0, At, B0); PG8_MMA(1, 1, At, B1); PG8_BAR; PG8_SCHED;
            PG8_LDB(B0, 1, 0); PG8_LDB(B1, 1, 1); PG8_SCHED; PG8_LDA(At, 1, 0); PG8_STAGE(PG8_SA(0, 1), a2 + hstep, voffA);
            PG8_WAIT_V(8); PG8_WAIT_L(0); PG8_BAR; PG8_MMA(0, 0, At, B0); PG8_MMA(0, 1, At, B1); PG8_BAR; PG8_SCHED;
            PG8_LDA(At, 1, 1); PG8_STAGE(PG8_SB(1, 0), b3, voffB); PG8_STAGE(PG8_SB(1, 1), b3 + hstep, voffB); PG8_STAGE(PG8_SA(1, 0), a3, voffA);
            PG8_WAIT_V(8); PG8_WAIT_L(0); PG8_BAR; PG8_MMA(1, 0, At, B0); PG8_MMA(1, 1, At, B1); PG8_BAR; PG8_SCHED;
            } else {
            PG8_LDB(B0, 0, 0); PG8_SCHED; PG8_LDA(At, 0, 0); PG8_STAGE(PG8_SA(1, 1), a1 + hstep, voffA);
            PG8_WAIT_L(8); PG8_BAR; PG8_WAIT_L(0); PG8_MMA(0, 0, At, B0); PG8_BAR; PG8_SCHED;
            PG8_LDB(B1, 0, 1); PG8_STAGE(PG8_SB(0, 0), b2, voffB);
            PG8_BAR; PG8_WAIT_L(0); PG8_MMA(0, 1, At, B1); PG8_BAR;
            PG8_LDA(At, 0, 1); PG8_STAGE(PG8_SA(0, 0), a2, voffA);
            PG8_BAR; PG8_WAIT_L(0); PG8_MMA(1, 0, At, B0); PG8_BAR; PG8_SCHED;
            PG8_STAGE(PG8_SB(0, 1), b2 + hstep, voffB);
            PG8_WAIT_V(6); PG8_BAR; PG8_MMA(1, 1, At, B1); PG8_BAR;
            PG8_LDB(B0, 1, 0); PG8_SCHED; PG8_LDA(At, 1, 0); PG8_STAGE(PG8_SA(0, 1), a2 + hstep, voffA);
            PG8_WAIT_L(8); PG8_BAR; PG8_WAIT_L(0); PG8_MMA(0, 0, At, B0); PG8_BAR; PG8_SCHED;
            PG8_LDB(B1, 1, 1); PG8_STAGE(PG8_SB(1, 0), b3, voffB);
            PG8_BAR; PG8_WAIT_L(0); PG8_MMA(0, 1, At, B1); PG8_BAR;
            PG8_LDA(At, 1, 1); PG8_STAGE(PG8_SA(1, 0), a3, voffA);
            PG8_BAR; PG8_WAIT_L(0); PG8_MMA(1, 0, At, B0); PG8_BAR; PG8_SCHED;
            PG8_STAGE(PG8_SB(1, 1), b3 + hstep, voffB);
            PG8_WAIT_V(6); PG8_BAR; PG8_MMA(1, 1, At, B1); PG8_BAR;
            }
        }
        if constexpr (ALIGN_EPI) { if (wr == 0) PG8_BAR; }
        if constexpr (!Epi::AFTER_DRAIN) { E(acc, cur, wr, wc, fr, fq); S.done(cur); }
        if (!has_next) break;
#pragma unroll
        for (int a = 0; a < 2; ++a)
#pragma unroll
            for (int b = 0; b < 2; ++b)
#pragma unroll
                for (int m = 0; m < 4; ++m)
#pragma unroll
                    for (int n = 0; n < 2; ++n) acc[a][b][m][n] = (f32x4){0.f, 0.f, 0.f, 0.f};
        cur = nxt; cA = nA; cB = nB; ++ui;
        if constexpr (ALIGN_EPI) { if (wr == 1) PG8_BAR; }
    }
    PG8_WAIT_V(0);
    if constexpr (!ALIGN_EPI) { if (wr == 0) PG8_BAR; }
    PG8_BAR;
    if constexpr (Epi::AFTER_DRAIN) { E.fused(acc, cur, wr, wc, fr, fq, lds, wid, lane); S.done(cur); }
#undef PG8_SA
#undef PG8_SB
#undef PG8_STAGE
#undef PG8_LDA
#undef PG8_LDB
#undef PG8_MMA
#undef PG8_WAIT_V
#undef PG8_WAIT_L
#undef PG8_BAR
#undef PG8_SCHED
}
}
namespace epi {
using namespace pg8;
__device__ __forceinline__ float bflo(unsigned w) { return __uint_as_float(w << 16); }
__device__ __forceinline__ float bfhi(unsigned w) { return __uint_as_float(w & 0xffff0000u); }
__device__ __forceinline__ float sigm(float x) { return __builtin_amdgcn_rcpf(1.0f + __expf(-x)); }
__device__ __forceinline__ u32x4 pack8(f32x4 a, f32x4 b) { u32x4 w; w.x = cvt_pk_bf16(a[0], a[1]); w.y = cvt_pk_bf16(a[2], a[3]); w.z = cvt_pk_bf16(b[0], b[1]); w.w = cvt_pk_bf16(b[2], b[3]); return w; }
__device__ __forceinline__ void unpack8(u32x4 w, f32x4& a, f32x4& b) { a = (f32x4){bflo(w.x), bfhi(w.x), bflo(w.y), bfhi(w.y)}; b = (f32x4){bflo(w.z), bfhi(w.z), bflo(w.w), bfhi(w.w)}; }
#define EPI_LOOP(...) \
    _Pragma("unroll") for (int ai = 0; ai < 2; ++ai) _Pragma("unroll") for (int m = 0; m < 4; ++m) { const int row = u.pm * BM + ai * HALF + wr * 64 + m * 16 + fr; \
        _Pragma("unroll") for (int bj = 0; bj < 2; ++bj) { const int cl = bj * HALF + wc * 32 + 8 * fq; f32x4 v0 = acc[ai][bj][m][0], v1 = acc[ai][bj][m][1]; __VA_ARGS__ } }

struct EpiProj {
    static constexpr bool PERM = true, AFTER_DRAIN = false;
    bf16_t *QA, *KA, *VA, *QB, *KB, *VB, *RB, *GA, *GB; float* A1; float* out; const float* bfg; unsigned* kmax; const float* ggla;
    __device__ __forceinline__ void core(int row, int gc, f32x4 v0, f32x4 v1) const {
        const int pn = gc >> 8, cl = gc & 255;
        if (pn < 26) {
            bf16_t* dst; int ld, c0; float sc = 1.f; long fo_s = -1;
            if (pn < 2) { dst = QA; ld = 512; c0 = pn * 256; sc = 0.125f * 1.4426950408889634f; }
            else if (pn < 4) { dst = KA; ld = 512; c0 = (pn - 2) * 256; fo_s = (long)O_KS; }
            else if (pn < 6) { dst = VA; ld = 512; c0 = (pn - 4) * 256; fo_s = (long)O_VS; }
            else if (pn < 8) { dst = QB; ld = 512; c0 = (pn - 6) * 256; }
            else if (pn < 10) { dst = KB; ld = 512; c0 = (pn - 8) * 256; }
            else if (pn < 14) { dst = VB; ld = 1024; c0 = (pn - 10) * 256; }
            else if (pn < 18) { dst = RB; ld = 1024; c0 = (pn - 14) * 256; }
            else if (pn < 22) { dst = GA; ld = 1024; c0 = (pn - 18) * 256; }
            else { dst = GB; ld = 1024; c0 = (pn - 22) * 256; }
            const int col = c0 + cl;
            if (pn >= 14 && pn < 18) { const f32x4 g0 = *(const f32x4*)(ggla + col), g1 = *(const f32x4*)(ggla + col + 4);
                _Pragma("unroll") for (int i = 0; i < 4; ++i) { v0[i] = v0[i] * sigm(v0[i]) * g0[i]; v1[i] = v1[i] * sigm(v1[i]) * g1[i]; } }
            *(u32x4*)(dst + (size_t)row * ld + col) = pack8(v0 * sc, v1 * sc);
            if (fo_s >= 0) { float* fp = out + fo_s + (size_t)(row - MP) * 512 + col; *(f32x4*)fp = v0; *(f32x4*)(fp + 4) = v1; }
        } else if (cl < 8) { float* fp = out + O_FS + (size_t)(row - MP) * 8; f32x4 o0, o1;
            _Pragma("unroll") for (int i = 0; i < 4; ++i) { float z = v0[i] + bfg[i]; o0[i] = fminf(z, 0.f) - log1pf(expf(-fabsf(z))); z = v1[i] + bfg[4 + i]; o1[i] = fminf(z, 0.f) - log1pf(expf(-fabsf(z))); }
            *(f32x4*)fp = o0; *(f32x4*)(fp + 4) = o1;
        } else if (cl < 24) { float* fp = A1 + (size_t)row * 16 + (cl - 8); *(f32x4*)fp = v0; *(f32x4*)(fp + 4) = v1; }
    }
    __device__ __forceinline__ void operator()(const f32x4 (&acc)[2][2][4][2], const Unit& u, int wr, int wc, int fr, int fq) const {
        const int pn = u.pn;
        if (pn < 26) {
            bf16_t* dst; int ld, c0; float sc = 1.f; long fo_p = -1, fo_s = -1;
            if (pn < 2) { dst = QA; ld = 512; c0 = pn * 256; sc = 0.125f * 1.4426950408889634f; }
            else if (pn < 4) { dst = KA; ld = 512; c0 = (pn - 2) * 256; fo_p = (long)O_KP; fo_s = (long)O_KS; }
            else if (pn < 6) { dst = VA; ld = 512; c0 = (pn - 4) * 256; fo_p = (long)O_VP; fo_s = (long)O_VS; }
            else if (pn < 8) { dst = QB; ld = 512; c0 = (pn - 6) * 256; }
            else if (pn < 10) { dst = KB; ld = 512; c0 = (pn - 8) * 256; }
            else if (pn < 14) { dst = VB; ld = 1024; c0 = (pn - 10) * 256; }
            else if (pn < 18) { dst = RB; ld = 1024; c0 = (pn - 14) * 256; }
            else if (pn < 22) { dst = GA; ld = 1024; c0 = (pn - 18) * 256; }
            else { dst = GB; ld = 1024; c0 = (pn - 22) * 256; }
            const bool trk = (pn == 2 || pn == 3) && u.pm < 256; float km0 = 0.f, km1 = 0.f;
            EPI_LOOP({ const int col = c0 + cl;
                if (trk) { float sq = (v0[0] * v0[0] + v0[1] * v0[1]) + (v0[2] * v0[2] + v0[3] * v0[3]) + (v1[0] * v1[0] + v1[1] * v1[1]) + (v1[2] * v1[2] + v1[3] * v1[3]);
                    sq += __shfl_xor(sq, 16); sq += __shfl_xor(sq, 32);
                    if (bj == 0) km0 = fmaxf(km0, sq); else km1 = fmaxf(km1, sq); }
                if (pn >= 14 && pn < 18) { const f32x4 g0 = *(const f32x4*)(ggla + col), g1 = *(const f32x4*)(ggla + col + 4);
                    _Pragma("unroll") for (int i = 0; i < 4; ++i) { v0[i] = v0[i] * sigm(v0[i]) * g0[i]; v1[i] = v1[i] * sigm(v1[i]) * g1[i]; } }
                __builtin_nontemporal_store(pack8(v0 * sc, v1 * sc), (u32x4*)(dst + (size_t)row * ld + col));
                if (fo_p >= 0 && row < MROWS) { float* fp = row < MP ? out + fo_p + (size_t)row * 512 + col : out + fo_s + (size_t)(row - MP) * 512 + col; __builtin_nontemporal_store(v0, (f32x4*)fp); __builtin_nontemporal_store(v1, (f32x4*)(fp + 4)); } })
            if (trk) {
#pragma unroll
                for (int o_ = 1; o_ < 64; o_ <<= 1) { km0 = fmaxf(km0, __shfl_xor(km0, o_)); km1 = fmaxf(km1, __shfl_xor(km1, o_)); }
                if ((fr | fq) == 0) { const int bb = (u.pm * BM) >> 13, hd = (pn - 2) * 4 + (wc >> 1);
                    atomicMax(kmax + ((bb * 8 + hd) * 2 + (wc & 1)), __float_as_uint(km0)); atomicMax(kmax + ((bb * 8 + hd + 2) * 2 + (wc & 1)), __float_as_uint(km1)); } }
        } else {
            if (wc == 0) {
                EPI_LOOP({ if (bj == 0) {
                    if (fq == 0) { if (row < MROWS) { float* fp = row < MP ? out + O_FP + (size_t)row * 8 : out + O_FS + (size_t)(row - MP) * 8;
                            f32x4 o0, o1;
                            _Pragma("unroll") for (int i = 0; i < 4; ++i) { float z = v0[i] + bfg[i]; o0[i] = fminf(z, 0.f) - log1pf(expf(-fabsf(z))); z = v1[i] + bfg[4 + i]; o1[i] = fminf(z, 0.f) - log1pf(expf(-fabsf(z))); }
                            *(f32x4*)fp = o0; *(f32x4*)(fp + 4) = o1; } }
                    else if (fq < 3) { float* fp = A1 + (size_t)row * 16 + (fq - 1) * 8; *(f32x4*)fp = v0; *(f32x4*)(fp + 4) = v1; } } })
            }
        }
    }
};
template <int SECOND> struct EpiMerge {
    static constexpr bool PERM = true, AFTER_DRAIN = false;
    const bf16_t* G; bf16_t* MG;
    __device__ __forceinline__ void core(int row, int gc, f32x4 v0, f32x4 v1) const {
        const size_t off = (size_t)row * 1024 + gc; f32x4 g0, g1; unpack8(__builtin_nontemporal_load((const u32x4*)(G + off)), g0, g1);
        _Pragma("unroll") for (int i = 0; i < 4; ++i) { v0[i] *= sigm(g0[i]); v1[i] *= sigm(g1[i]); }
        if (SECOND) { f32x4 p0, p1; unpack8(*(const u32x4*)(MG + off), p0, p1); v0 += p0; v1 += p1; }
        *(u32x4*)(MG + off) = pack8(v0, v1);
    }
    __device__ __forceinline__ void operator()(const f32x4 (&acc)[2][2][4][2], const Unit& u, int wr, int wc, int fr, int fq) const {
        EPI_LOOP({ core(row, u.pn * BM + cl, v0, v1); })
    }
};
struct EpiResX {
    static constexpr bool PERM = true, AFTER_DRAIN = false;
    const float* xp; const float* xs; bf16_t* Z;
    __device__ __forceinline__ void core(int row, int gc, f32x4 v0, f32x4 v1) const {
        const size_t off = (size_t)row * 1024 + gc; f32x4 x0 = {0.f, 0.f, 0.f, 0.f}, x1 = {0.f, 0.f, 0.f, 0.f};
        if (row < MROWS) { const float* b = row < MP ? xp + off : xs + (off - (size_t)MP * 1024); x0 = *(const f32x4*)b; x1 = *(const f32x4*)(b + 4); }
        *(u32x4*)(Z + off) = pack8(x0 * ALPHA + v0, x1 * ALPHA + v1);
    }
    __device__ __forceinline__ void operator()(const f32x4 (&acc)[2][2][4][2], const Unit& u, int wr, int wc, int fr, int fq) const {
        EPI_LOOP({ core(row, u.pn * BM + cl, v0, v1); })
    }
};
template <int MUL> struct EpiResB {
    static constexpr bool PERM = true, AFTER_DRAIN = false;
    const bf16_t* bb; bf16_t* Z; const bf16_t* mul;
    __device__ __forceinline__ void core(int row, int gc, f32x4 v0, f32x4 v1) const {
        const size_t off = (size_t)row * 1024 + gc; f32x4 x0, x1; unpack8(*(const u32x4*)(bb + off), x0, x1);
        if (MUL) { f32x4 m0, m1; unpack8(*(const u32x4*)(mul + off), m0, m1);
            _Pragma("unroll") for (int i = 0; i < 4; ++i) { v0[i] = m0[i] * sigm(v0[i]); v1[i] = m1[i] * sigm(v1[i]); } }
        *(u32x4*)(Z + off) = pack8(x0 * ALPHA + v0, x1 * ALPHA + v1);
    }
    __device__ __forceinline__ void operator()(const f32x4 (&acc)[2][2][4][2], const Unit& u, int wr, int wc, int fr, int fq) const {
        EPI_LOOP({ core(row, u.pn * BM + cl, v0, v1); })
    }
};
struct EpiStore {
    static constexpr bool PERM = true, AFTER_DRAIN = false;
    bf16_t* T;
    __device__ __forceinline__ void core(int row, int gc, f32x4 v0, f32x4 v1) const { *(u32x4*)(T + (size_t)row * 1024 + gc) = pack8(v0, v1); }
    __device__ __forceinline__ void operator()(const f32x4 (&acc)[2][2][4][2], const Unit& u, int wr, int wc, int fr, int fq) const {
        EPI_LOOP({ core(row, u.pn * BM + cl, v0, v1); })
    }
};
struct EpiUp {
    static constexpr bool PERM = true, AFTER_DRAIN = false;
    bf16_t* UP; float* out; int half;
    __device__ __forceinline__ void core(int row, int gc, f32x4 v0, f32x4 v1) const {
        *(u32x4*)(UP + (size_t)row * DFF + gc) = pack8(v0, v1);
        const int t = (row - MP) & 15;
        if (t >= 14) { const int jg = half * 11 + (gc >> 8), cl = gc & 255; const int oc = (cl < 128 ? 0 : DFF - 128) + 128 * jg + cl;
            float* fp = out + O_CS + ((size_t)((row - MP) >> 4) * 2 + (t - 14)) * 5632 + oc; *(f32x4*)fp = v0; *(f32x4*)(fp + 4) = v1; }
    }
    __device__ __forceinline__ void operator()(const f32x4 (&acc)[2][2][4][2], const Unit& u, int wr, int wc, int fr, int fq) const {
        const int jg = half * 11 + u.pn;
        EPI_LOOP({ __builtin_nontemporal_store(pack8(v0, v1), (u32x4*)(UP + (size_t)row * DFF + u.pn * BM + cl));
            long fo = -1;
            if (row < MP) { const int t = row & (TSEQ - 1); if (t >= TSEQ - 2) fo = (long)O_CP + ((long)(row >> 13) * 2 + (t - (TSEQ - 2))) * 5632; }
            else if (row < MROWS) { const int t = (row - MP) & 15; if (t >= 14) fo = (long)O_CS + ((long)((row - MP) >> 4) * 2 + (t - 14)) * 5632; }
            if (fo >= 0) { const int oc = (bj == 0 ? 0 : DFF) + 128 * jg + wc * 32 + 8 * fq; float* fp = out + fo + oc; *(f32x4*)fp = v0; *(f32x4*)(fp + 4) = v1; } })
    }
};
template <class Epi> __device__ __forceinline__ void light_gemm(const bf16_t* __restrict__ A, const bf16_t* __restrict__ Bt, int N, int K, const Epi& E, int wv, int bx, int G, PG8_LAS unsigned char* lds) {
    const int lane = lane_id_asm(), l15 = lane & 15, kq = lane >> 4;
    const int ks = K >> 3;
    PG8_LAS f32x4* RED = (PG8_LAS f32x4*)lds;
    for (int un = bx; un < (N >> 2); un += G) {
        const int rb = un & 7, n0 = 32 * (un >> 3);
        const bf16_t* ap = A + (size_t)(MP + 16 * rb + l15) * K + wv * ks + 8 * kq;
        const bf16_t* w0 = Bt + (size_t)(n0 + 8 * (l15 >> 2) + (l15 & 3)) * K + wv * ks + 8 * kq; const bf16_t* w1 = w0 + (size_t)4 * K;
        f32x4 c0 = {0.f, 0.f, 0.f, 0.f}, c1 = {0.f, 0.f, 0.f, 0.f};
#pragma unroll 4
        for (int k = 0; k < ks; k += 32) { const bf16x8 af = *(const bf16x8*)(ap + k), b0 = *(const bf16x8*)(w0 + k), b1 = *(const bf16x8*)(w1 + k);
            c0 = __builtin_amdgcn_mfma_f32_16x16x32_bf16(b0, af, c0, 0, 0, 0); c1 = __builtin_amdgcn_mfma_f32_16x16x32_bf16(b1, af, c1, 0, 0, 0); }
        RED[(wv * 64 + lane) * 2] = c0; RED[(wv * 64 + lane) * 2 + 1] = c1;
        __syncthreads();
        if (wv == 0) {
#pragma unroll
            for (int w = 1; w < 8; ++w) { c0 += RED[(w * 64 + lane) * 2]; c1 += RED[(w * 64 + lane) * 2 + 1]; }
            E.core(MP + 16 * rb + l15, n0 + 8 * kq, c0, c1);
        }
        __syncthreads();
    }
}
template <class Epi> __device__ __forceinline__ void light_gemm_wide(const bf16_t* __restrict__ A, const bf16_t* __restrict__ Bt, int N, int K, const Epi& E, int wv, int bx, int G, PG8_LAS unsigned char* lds) {
    const int lane = lane_id_asm(), l15 = lane & 15, kq = lane >> 4;
    const int ks = K >> 1, rbl = wv & 3, kh = wv >> 2;
    PG8_LAS f32x4* RED = (PG8_LAS f32x4*)lds;
    for (int un = bx; un < (N >> 4); un += G) {
        const int rb = 4 * (un & 1) + rbl, n0 = 32 * (un >> 1);
        const bf16_t* ap = A + (size_t)(MP + 16 * rb + l15) * K + kh * ks + 8 * kq;
        const bf16_t* w0 = Bt + (size_t)(n0 + 8 * (l15 >> 2) + (l15 & 3)) * K + kh * ks + 8 * kq; const bf16_t* w1 = w0 + (size_t)4 * K;
        f32x4 c0 = {0.f, 0.f, 0.f, 0.f}, c1 = {0.f, 0.f, 0.f, 0.f};
#pragma unroll 8
        for (int k = 0; k < ks; k += 32) { const bf16x8 af = *(const bf16x8*)(ap + k), b0 = *(const bf16x8*)(w0 + k), b1 = *(const bf16x8*)(w1 + k);
            c0 = __builtin_amdgcn_mfma_f32_16x16x32_bf16(b0, af, c0, 0, 0, 0); c1 = __builtin_amdgcn_mfma_f32_16x16x32_bf16(b1, af, c1, 0, 0, 0); }
        if (kh == 1) { RED[(rbl * 64 + lane) * 2] = c0; RED[(rbl * 64 + lane) * 2 + 1] = c1; }
        __syncthreads();
        if (kh == 0) { c0 += RED[(rbl * 64 + lane) * 2]; c1 += RED[(rbl * 64 + lane) * 2 + 1]; E.core(MP + 16 * rb + l15, n0 + 8 * kq, c0, c1); }
        __syncthreads();
    }
}
}
#include <hip/hip_bf16.h>
#include <cmath>
namespace attn_body {
using bf16=__hip_bfloat16;
using bf16x8=__attribute__((ext_vector_type(8)))short;
using s16x4=__attribute__((ext_vector_type(4)))short;
using f32x16=__attribute__((ext_vector_type(16)))float;
using u32x4=__attribute__((ext_vector_type(4)))unsigned;
using f32x4a=__attribute__((ext_vector_type(4)))float;
__device__ __forceinline__ __attribute__((address_space(3))) char* shm3f(char*p){return (__attribute__((address_space(3))) char*)p;}
constexpr int BATCH=8,NHEAD=8,SEQ=8192,D=64,DM=NHEAD*D;
constexpr int NW=8,QBLK=32,QB=QBLK*NW,KVBLK=64,NQB=SEQ/QB;
constexpr int ATTN_PITCH=DM, ATTN_UNIT_ROWS=QB;
__device__ __forceinline__ int crow(int r,int hi){return (r&3)+8*(r>>2)+4*hi;}
#define SBAR() __builtin_amdgcn_sched_barrier(0)
__device__ __forceinline__ void cmask(f32x16&p0,f32x16&p1,int jb,int qrel,int hi){
  const float NEG=-INFINITY; int kb=64*jb+4*hi;
  #pragma unroll
  for(int r=0;r<16;++r){int kv=kb+(r&3)+8*(r>>2); if(kv>qrel)p0[r]=NEG; if(kv+32>qrel)p1[r]=NEG;}
}

constexpr int NSLOT=3, SLOTB=8192;
constexpr int LDS_K=0, LDS_V=NSLOT*SLOTB, LDS_WS=2*NSLOT*SLOTB, LDS_OST=LDS_WS+NW*64*4, LDS_CB=LDS_OST+NW*4096, LDS_BYTES=LDS_CB+(SEQ+128)*4;
constexpr float C2=0.125f*1.4426950408889634f;
__device__ __forceinline__ void glds16(const void*gsrc,unsigned lds_dst){unsigned keep;
  asm volatile("s_mov_b32 %0, m0\n\ts_mov_b32 m0, %2\n\ts_nop 0\n\tglobal_load_lds_dwordx4 %1, off\n\ts_mov_b32 m0, %0":"=&s"(keep):"v"(gsrc),"s"(lds_dst):"memory");}
__device__ __forceinline__ float max3f(float a,float b,float c){float r;asm("v_max3_f32 %0, %1, %2, %3":"=v"(r):"v"(a),"v"(b),"v"(c));return r;}
__device__ __forceinline__ float max2f(float a,float b){float r;asm("v_max_f32_e32 %0, %1, %2":"=v"(r):"v"(a),"v"(b));return r;}
__device__ __forceinline__ float fadd_s(float a,float b){float r;asm("v_add_f32_e32 %0, %1, %2":"=v"(r):"v"(a),"v"(b));return r;}
__device__ __forceinline__ float fsub_s(float a,float b){float r;asm("v_sub_f32_e32 %0, %1, %2":"=v"(r):"v"(a),"v"(b));return r;}
typedef float f32x2_t __attribute__((ext_vector_type(2))); typedef __bf16 bf16x2_t __attribute__((ext_vector_type(2)));
__device__ __forceinline__ unsigned cvtpk_s(float lo,float hi){f32x2_t v={lo,hi};bf16x2_t b=__builtin_convertvector(v,bf16x2_t);return __builtin_bit_cast(unsigned,b);}
#define WAIT_BAR(N) asm volatile("s_waitcnt vmcnt(" #N ") lgkmcnt(0)\n\ts_barrier":::"memory")

__device__ __forceinline__ void qkt(f32x16&p0,f32x16&p1,const char*Kslot,const bf16x8*qr,int r32,int hi){
  const char*kb=Kslot+hi*1024+r32*16;
  #pragma unroll
  for(int d0=0;d0<4;++d0){
    const bf16x8 b0=*reinterpret_cast<const bf16x8*>(kb+d0*2048);
    const bf16x8 b1=*reinterpret_cast<const bf16x8*>(kb+d0*2048+512);
    p0=__builtin_amdgcn_mfma_f32_32x32x16_bf16(b0,qr[d0],p0,0,0,0);p1=__builtin_amdgcn_mfma_f32_32x32x16_bf16(b1,qr[d0],p1,0,0,0);}
}
typedef __attribute__((address_space(3))) const char* lds_cptr;
typedef short v4i16_t __attribute__((ext_vector_type(4)));
__device__ __forceinline__ void kload8(bf16x8*kf,lds_cptr kp){
  kf[0]=*(const __attribute__((address_space(3))) bf16x8*)(kp);      kf[1]=*(const __attribute__((address_space(3))) bf16x8*)(kp+512);
  kf[2]=*(const __attribute__((address_space(3))) bf16x8*)(kp+2048); kf[3]=*(const __attribute__((address_space(3))) bf16x8*)(kp+2560);
  kf[4]=*(const __attribute__((address_space(3))) bf16x8*)(kp+4096); kf[5]=*(const __attribute__((address_space(3))) bf16x8*)(kp+4608);
  kf[6]=*(const __attribute__((address_space(3))) bf16x8*)(kp+6144); kf[7]=*(const __attribute__((address_space(3))) bf16x8*)(kp+6656);
}
__device__ __forceinline__ void kload2(bf16x8*kf,lds_cptr kp,int j){ kf[2*j]=*(const __attribute__((address_space(3))) bf16x8*)(kp+j*2048); kf[2*j+1]=*(const __attribute__((address_space(3))) bf16x8*)(kp+j*2048+512); }
__device__ __forceinline__ s16x4 vtr(lds_cptr p){ return __builtin_bit_cast(s16x4,__builtin_amdgcn_ds_read_tr16_b64_v4i16((__attribute__((address_space(3))) v4i16_t*)p)); }
__device__ __forceinline__ float rowmax(const f32x16&p0,const f32x16&p1){
  float a=max3f(p0[0],p0[1],p1[0]),b=max3f(p0[2],p0[3],p1[1]);a=max3f(a,p1[2],p1[3]);
  #pragma unroll
  for(int r=4;r<16;r+=4){a=max3f(a,p0[r],p0[r+1]);b=max3f(b,p0[r+2],p0[r+3]);a=max3f(a,p1[r],p1[r+1]);b=max3f(b,p1[r+2],p1[r+3]);}
  const float m=max2f(a,b);
  auto rr=__builtin_amdgcn_permlane32_swap(__float_as_uint(m),__float_as_uint(m),false,false);
  return max2f(__uint_as_float(rr[0]),__uint_as_float(rr[1]));
}
__device__ __forceinline__ void pv(f32x16*o,int vb,bf16x8 pa0,bf16x8 pa1,bf16x8 pa2,bf16x8 pa3){
  #pragma unroll
  for(int d0=0;d0<2;++d0){s16x4 lo[4],hi[4];
    #pragma unroll
    for(int ks=0;ks<4;++ks){
      asm volatile("ds_read_b64_tr_b16 %0,%1 offset:%c2":"=&v"(lo[ks]):"v"(vb),"i"(d0*4096+ks*1024):"memory");
      asm volatile("ds_read_b64_tr_b16 %0,%1 offset:%c2":"=&v"(hi[ks]):"v"(vb),"i"(d0*4096+ks*1024+512):"memory");}
    asm volatile("s_waitcnt lgkmcnt(0)":::"memory");SBAR();
    #define PK(k) (bf16x8){lo[k][0],lo[k][1],lo[k][2],lo[k][3],hi[k][0],hi[k][1],hi[k][2],hi[k][3]}
    o[d0]=__builtin_amdgcn_mfma_f32_32x32x16_bf16(pa0,PK(0),o[d0],0,0,0);
    o[d0]=__builtin_amdgcn_mfma_f32_32x32x16_bf16(pa1,PK(1),o[d0],0,0,0);
    o[d0]=__builtin_amdgcn_mfma_f32_32x32x16_bf16(pa2,PK(2),o[d0],0,0,0);
    o[d0]=__builtin_amdgcn_mfma_f32_32x32x16_bf16(pa3,PK(3),o[d0],0,0,0);
    #undef PK
  }
}

#ifndef ATTN_STORE16
#define ATTN_STORE16(p,v) __builtin_nontemporal_store((v),(u32x4*)(p))
#endif
__device__ __forceinline__ void cb_scan(int b,int h,const float*__restrict__ logf,float*__restrict__ cbg,char*shm,const int wv){
  const int tid=TIDX(wv),lane=tid&63,wid=wv; typedef __attribute__((address_space(3))) float lds_f32;
  lds_f32* ws_=(lds_f32*)shm3f(shm); const int j0=16*tid; float sv[16]; float run=0.f;
  const float*lp=logf+((long)b*SEQ+j0)*NHEAD+h;
  _Pragma("unroll") for(int i=0;i<16;++i){ run+=lp[(long)i*NHEAD]; sv[i]=run; }
  float incl=run;
  _Pragma("unroll") for(int o_=1;o_<64;o_<<=1){ const float n_=__shfl_up(incl,o_); if(lane>=o_)incl+=n_; }
  if(lane==63)ws_[wid]=incl;
  __syncthreads();
  float wp=0.f; _Pragma("unroll") for(int w_=0;w_<NW;++w_){ const float x_=ws_[w_]; if(w_<wid)wp+=x_; }
  const float off_=wp+incl-run; float*og=cbg+(long)(b*NHEAD+h)*SEQ+j0;
  _Pragma("unroll") for(int i=0;i<16;++i) og[i]=-(off_+sv[i])*1.4426950408889634f;
  __syncthreads();
}
template<int THRL> __device__ __forceinline__ void attn_unit(int b,int h,int qb,const bf16*Q,const bf16*__restrict__ K,const bf16*__restrict__ V,bf16*O,const float*__restrict__ logf,const float*__restrict__ kmaxp,char*shm,const int wv){
  const int tid=TIDX(wv),lane=tid&63,r32=lane&31,hi=lane>>5; const int wid=wv;
  const long rowbase=(long)b*SEQ; const int q0=qb*QB;
  const bf16*Qw=Q+(rowbase+q0+wid*QBLK)*DM+h*D;
  typedef __attribute__((address_space(3))) float lds_f32; typedef __attribute__((address_space(3))) const float* lds_cf32p;
  { lds_f32* cbw=(lds_f32*)(shm3f(shm)+LDS_CB); const float* cg_=logf+(long)(b*NHEAD+h)*SEQ; const int NK=q0+QB;
    for(int j=4*tid;j<NK;j+=2048) *(__attribute__((address_space(3))) f32x4a*)(cbw+j)=*(const f32x4a*)(cg_+j); }
  bf16x8 qr[4];
  #pragma unroll
  for(int d0=0;d0<4;++d0)qr[d0]=*reinterpret_cast<const bf16x8*>(&Qw[(long)r32*DM+d0*16+hi*8]);
  int T0=0;
  { float q1=0.f;
    _Pragma("unroll") for(int d0=0;d0<4;++d0) _Pragma("unroll") for(int j=0;j<8;++j){ const float x_=__uint_as_float(((unsigned)(unsigned short)qr[d0][j])<<16); q1+=x_*x_; }
    q1+=__shfl_xor(q1,32);
    _Pragma("unroll") for(int o_=1;o_<32;o_<<=1) q1=fmaxf(q1,__shfl_xor(q1,o_));
    lds_f32* cbw=(lds_f32*)(shm3f(shm)+LDS_CB);
    if(lane==0)cbw[SEQ+80+wid]=q1;
    __syncthreads();
    float qm=0.f; _Pragma("unroll") for(int w_=0;w_<NW;++w_) qm=fmaxf(qm,cbw[SEQ+80+w_]);
    const float B2=2.04f*sqrtf(qm*(kmaxp[(b*NHEAD+h)*2]+kmaxp[(b*NHEAD+h)*2+1]));
    const int NT0=(q0+QB)/KVBLK;
    const bool skip=(tid<NT0-4)&&(B2+cbw[64*tid+63]-cbw[q0]<-160.f);
    const int cnt=__syncthreads_count(skip?1:0);
    T0=cnt&~1; if(T0>NT0-4)T0=NT0-4; if(T0<0)T0=0; T0=__builtin_amdgcn_readfirstlane(T0); }
  const bf16*Kh=K+(rowbase+(long)T0*KVBLK)*DM+h*D,*Vh=V+(rowbase+(long)T0*KVBLK)*DM+h*D;
  const unsigned lds0=(unsigned)(uintptr_t)shm;
  float*wsf=(float*)(shm+LDS_WS)+wid*64;
  const bf16*ksrc=Kh+(long)lane*DM+wid*8;
  const bf16*vsrc=Vh+(long)(16*(wid&3)+(lane>>2))*DM+(wid>>2)*32+(lane&3)*8;
  const unsigned kdst=lds0+LDS_K+wid*1024, vdst=lds0+LDS_V+wid*1024;
  #define DMA_K(t,slot) glds16(ksrc+(long)(t)*KVBLK*DM,(unsigned)__builtin_amdgcn_readfirstlane(kdst+(slot)))
  #define DMA_V(t,slot) glds16(vsrc+(long)(t)*KVBLK*DM,(unsigned)__builtin_amdgcn_readfirstlane(vdst+(slot)))
  const int vb0=(int)(lds0+LDS_V)+((lane>>4)&1)*32+(lane&3)*8+(4*hi+((lane&15)>>2))*64;
  const char*Kbase=shm+LDS_K; bf16x8 kf[8];
  const lds_cptr shm3=(lds_cptr)shm; const lds_cptr kp0=shm3+LDS_K+hi*1024+r32*16; const lds_cptr vp0=shm3+LDS_V+((lane>>4)&1)*32+(lane&3)*8+(4*hi+((lane&15)>>2))*64;
  const int NT=(q0+QB)/KVBLK-T0;
  const lds_cf32p cbL=(lds_cf32p)(shm3f(shm)+LDS_CB)+4*hi+T0*KVBLK;
  #define LOADB(X0,X1,tt) do{ const lds_cf32p cp_=cbL+(tt)*64; \
    _Pragma("unroll") for(int g_=0;g_<4;++g_){ const f32x4a a_=*(const __attribute__((address_space(3))) f32x4a*)(cp_+8*g_); const f32x4a b_=*(const __attribute__((address_space(3))) f32x4a*)(cp_+32+8*g_); \
      X0[4*g_]=a_[0]-mhat; X0[4*g_+1]=a_[1]-mhat; X0[4*g_+2]=a_[2]-mhat; X0[4*g_+3]=a_[3]-mhat; \
      X1[4*g_]=b_[0]-mhat; X1[4*g_+1]=b_[1]-mhat; X1[4*g_+2]=b_[2]-mhat; X1[4*g_+3]=b_[3]-mhat; } }while(0)
  DMA_K(0,0);DMA_V(0,0);DMA_K(1,SLOTB);
  float mhat=0.f,l_reg=0.f;f32x16 o[2];o[0]=f32x16{};o[1]=f32x16{};
  const int qrel=wid*QBLK+r32;
  f32x16 pA0,pA1,pB0,pB1; LOADB(pA0,pA1,0);
  #define CMASK(P0,P1,t) do{int jb_=(t)-(NT-4); if(jb_>=0)cmask(P0,P1,jb_,qrel,hi);}while(0)
  bool resc=false;
  #define START(P0,P1) do{ const float rm=rowmax(P0,P1); resc=false; \
    { const float dl=rm; mhat=fadd_s(mhat,dl); \
      _Pragma("unroll") for(int r=0;r<16;++r){P0[r]=fsub_s(P0[r],dl);P1[r]=fsub_s(P1[r],dl);} } \
    _Pragma("unroll") for(int r=0;r<16;++r)P0[r]=__builtin_amdgcn_exp2f(P0[r]); }while(0)
  #define RESC() do{ if(resc){ asm volatile("s_waitcnt lgkmcnt(0)":::"memory"); \
      _Pragma("unroll") for(int d_=0;d_<2;++d_) _Pragma("unroll") for(int r=0;r<16;++r)o[d_][r]*=wsf[crow(r,hi)]; } }while(0)
  int sl_prev=0,sl_cur=0,sl_next=SLOTB;
  #define ROT() do{sl_prev=sl_cur;sl_cur=sl_next;sl_next=(sl_next==(NSLOT-1)*SLOTB)?0:sl_next+SLOTB;}while(0)
  DMA_K(2,2*SLOTB);
  WAIT_BAR(3);
  qkt(pA0,pA1,Kbase,qr,r32,hi);asm volatile("s_nop 15\n\ts_nop 7":"+v"(pA0),"+v"(pA1));CMASK(pA0,pA1,0);
  START(pA0,pA1);
  LOADB(pB0,pB1,1);
  _Pragma("unroll") for(int r=0;r<16;++r)pA1[r]=__builtin_amdgcn_exp2f(pA1[r]);
  WAIT_BAR(0);
  DMA_K(3,0);DMA_V(1,SLOTB);
  ROT();
  kload8(kf,kp0+sl_cur);
  WAIT_BAR(2);
  s16x4 vlo[8],vhi[8]; u32x4 pw0,pw1,pw2,pw3;
  #define PKW(P,B) cvtpk_s(P[B],P[B+1])
  #define PAF(k) __builtin_bit_cast(bf16x8,pw##k)
  #define VFR(i) (bf16x8){vlo[i][0],vlo[i][1],vlo[i][2],vlo[i][3],vhi[i][0],vhi[i][1],vhi[i][2],vhi[i][3]}
  #define PIN(x) asm volatile("":"+v"(x))
  #define MX3(a,b,c) __builtin_fmaxf(__builtin_fmaxf((a),(b)),(c))
  #define GAPA(MF,A0,A1,A2,A3,W0,W1,PW) do{ MF; sacc+=A0; sacc+=A1; sacc+=A2; sacc+=A3; PIN(sacc); W0; W1; PIN(PW); SBAR(); }while(0)
  #define EX(v) __builtin_amdgcn_exp2f(v)
  #define GAPB(MF,X,B) do{ MF; X[B]=EX(X[B]); X[B+1]=EX(X[B+1]); X[B+2]=EX(X[B+2]); X[B+3]=EX(X[B+3]); PIN(X); SBAR(); }while(0)
  #define VRD(i) do{ vlo[i]=vtr(vp_+(((i)>>2)*4096+((i)&3)*1024)); vhi[i]=vtr(vp_+(((i)>>2)*4096+((i)&3)*1024+512)); }while(0)
  #define KRD(G,j) do{ if(G){ kload2(kf,kp0+sl_next,j); SBAR(); } }while(0)
  #define STEP(C0,C1,P0,P1,t,GK,GV,GL) do{ SBAR(); \
    const lds_cptr vp_=vp0+sl_prev; \
    VRD(0); SBAR(); float sacc=(P0[0]+P0[1]); \
    GAPA(C0=__builtin_amdgcn_mfma_f32_32x32x16_bf16(kf[0],qr[0],C0,0,0,0), P0[2],P0[3],P0[4],P0[5],     pw0[0]=PKW(P0,0), pw0[1]=PKW(P0,2), pw0); \
    VRD(4); SBAR(); GAPA(C1=__builtin_amdgcn_mfma_f32_32x32x16_bf16(kf[1],qr[0],C1,0,0,0), P0[6],P0[7],P0[8],P0[9],     pw0[2]=PKW(P0,4), pw0[3]=PKW(P0,6), pw0); \
    VRD(1); SBAR(); GAPA(C0=__builtin_amdgcn_mfma_f32_32x32x16_bf16(kf[2],qr[1],C0,0,0,0),   P0[10],P0[11],P0[12],P0[13], pw1[0]=PKW(P0,8), pw1[1]=PKW(P0,10), pw1); \
    VRD(5); SBAR(); GAPA(C1=__builtin_amdgcn_mfma_f32_32x32x16_bf16(kf[3],qr[1],C1,0,0,0),   P0[14],P0[15],P1[0],P1[1],   pw1[2]=PKW(P0,12),pw1[3]=PKW(P0,14), pw1); \
    VRD(2); SBAR(); GAPA(C0=__builtin_amdgcn_mfma_f32_32x32x16_bf16(kf[4],qr[2],C0,0,0,0),   P1[2],P1[3],P1[4],P1[5],     pw2[0]=PKW(P1,0), pw2[1]=PKW(P1,2), pw2); \
    VRD(6); SBAR(); GAPA(C1=__builtin_amdgcn_mfma_f32_32x32x16_bf16(kf[5],qr[2],C1,0,0,0),   P1[6],P1[7],P1[8],P1[9],     pw2[2]=PKW(P1,4), pw2[3]=PKW(P1,6), pw2); \
    VRD(3); SBAR(); GAPA(C0=__builtin_amdgcn_mfma_f32_32x32x16_bf16(kf[6],qr[3],C0,0,0,0),   P1[10],P1[11],P1[12],P1[13], pw3[0]=PKW(P1,8), pw3[1]=PKW(P1,10), pw3); \
    VRD(7); SBAR(); GAPA(C1=__builtin_amdgcn_mfma_f32_32x32x16_bf16(kf[7],qr[3],C1,0,0,0),   P1[14],P1[15],0.f,0.f,       pw3[2]=PKW(P1,12),pw3[3]=PKW(P1,14), pw3); \
    l_reg+=sacc; \
    if(GK){DMA_K((t)+3,sl_cur);} if(GV){DMA_V((t)+1,sl_next);} \
    CMASK(C0,C1,t); \
    { float a=MX3(C0[0],C0[1],C1[0]),b=MX3(C0[2],C0[3],C1[1]); a=MX3(a,C1[2],C1[3]); \
      _Pragma("unroll") for(int r=4;r<16;r+=4){a=MX3(a,C0[r],C0[r+1]);b=MX3(b,C0[r+2],C0[r+3]);a=MX3(a,C1[r],C1[r+1]);b=MX3(b,C1[r+2],C1[r+3]);} \
      float rm=__builtin_fmaxf(a,b); { auto rr=__builtin_amdgcn_permlane32_swap(__float_as_uint(rm),__float_as_uint(rm),false,false); rm=__builtin_fmaxf(__uint_as_float(rr[0]),__uint_as_float(rr[1])); } \
      resc=false; \
      if(__builtin_expect(__any(rm>(float)THRL),0)){ const float dl=__builtin_fmaxf(rm,0.f); mhat+=dl; \
        _Pragma("unroll") for(int r=0;r<16;++r){C0[r]-=dl;C1[r]-=dl;} \
        const float f=__builtin_amdgcn_exp2f(-dl); l_reg*=f; if(hi==0)wsf[r32]=f; resc=true; } } \
    SBAR(); \
    GAPB(o[0]=__builtin_amdgcn_mfma_f32_32x32x16_bf16(PAF(0),VFR(0),o[0],0,0,0), C0,0); \
    GAPB(o[1]=__builtin_amdgcn_mfma_f32_32x32x16_bf16(PAF(0),VFR(4),o[1],0,0,0), C0,4); \
    KRD(GL,0); GAPB(o[0]=__builtin_amdgcn_mfma_f32_32x32x16_bf16(PAF(1),VFR(1),o[0],0,0,0), C0,8); \
    KRD(GL,1); GAPB(o[1]=__builtin_amdgcn_mfma_f32_32x32x16_bf16(PAF(1),VFR(5),o[1],0,0,0), C0,12); \
    KRD(GL,2); GAPB(o[0]=__builtin_amdgcn_mfma_f32_32x32x16_bf16(PAF(2),VFR(2),o[0],0,0,0), C1,0); \
    KRD(GL,3); GAPB(o[1]=__builtin_amdgcn_mfma_f32_32x32x16_bf16(PAF(2),VFR(6),o[1],0,0,0), C1,4); \
    GAPB(o[0]=__builtin_amdgcn_mfma_f32_32x32x16_bf16(PAF(3),VFR(3),o[0],0,0,0), C1,8); \
    GAPB(o[1]=__builtin_amdgcn_mfma_f32_32x32x16_bf16(PAF(3),VFR(7),o[1],0,0,0), C1,12); \
    LOADB(P0,P1,(t)+1); \
    }while(0)
  int t=1;
  #undef CMASK
  #define CMASK(P0,P1,t) do{}while(0)
  for(;t+5<NT;t+=2){
    STEP(pB0,pB1,pA0,pA1,t,true,true,true);     WAIT_BAR(2); RESC(); ROT();
    STEP(pA0,pA1,pB0,pB1,t+1,true,true,true);   WAIT_BAR(2); RESC(); ROT();
  }
  #undef CMASK
  #define CMASK(P0,P1,t) do{int jb_=(t)-(NT-4); if(jb_>=0)cmask(P0,P1,jb_,qrel,hi);}while(0)
  #define ENDW(tt) do{ if((tt)+3<NT){WAIT_BAR(2);} else if((tt)+2<NT){WAIT_BAR(1);} else {WAIT_BAR(0);} }while(0)
  for(;t+1<NT;t+=2){
    STEP(pB0,pB1,pA0,pA1,t,(t+3<NT),(t+1<NT),(t+1<NT));       ENDW(t);   RESC(); ROT();
    STEP(pA0,pA1,pB0,pB1,t+1,(t+4<NT),(t+2<NT),(t+2<NT));     ENDW(t+1); RESC(); ROT();
  }
  STEP(pB0,pB1,pA0,pA1,NT-1,false,false,false); RESC();
  { float sacc=pB0[0]+pB0[1]; _Pragma("unroll") for(int r=2;r<16;++r)sacc+=pB0[r]; _Pragma("unroll") for(int r=0;r<16;++r)sacc+=pB1[r]; l_reg+=sacc;
    pw0=(u32x4){PKW(pB0,0),PKW(pB0,2),PKW(pB0,4),PKW(pB0,6)};pw1=(u32x4){PKW(pB0,8),PKW(pB0,10),PKW(pB0,12),PKW(pB0,14)};pw2=(u32x4){PKW(pB1,0),PKW(pB1,2),PKW(pB1,4),PKW(pB1,6)};pw3=(u32x4){PKW(pB1,8),PKW(pB1,10),PKW(pB1,12),PKW(pB1,14)};
    SBAR(); pv(o,vb0+sl_cur,PAF(0),PAF(1),PAF(2),PAF(3)); }
  #undef PKW
  #undef PAF
  #undef VFR
  #undef PIN
  #undef MX3
  #undef GAPA
  #undef GAPB
  #undef EX
  #undef VRD
  #undef KRD
  #undef STEP
  #undef ENDW
  {auto rr=__builtin_amdgcn_permlane32_swap(__float_as_uint(l_reg),__float_as_uint(l_reg),false,false);l_reg=__uint_as_float(rr[0])+__uint_as_float(rr[1]);}
  if(hi==0)wsf[32+r32]=l_reg;asm volatile("s_waitcnt lgkmcnt(0)":::"memory");
  float rli[16];
  #pragma unroll
  for(int r=0;r<16;++r)rli[r]=__builtin_amdgcn_rcpf(wsf[32+crow(r,hi)]);
  bf16*Ow=O+(rowbase+q0+wid*QBLK)*DM+h*D;
  { bf16*stg=(bf16*)(shm+LDS_OST)+wid*2048;
    #pragma unroll
    for(int r=0;r<16;++r){const int orow=crow(r,hi);
      #pragma unroll
      for(int d0=0;d0<2;++d0)stg[orow*64+d0*32+r32]=__float2bfloat16(o[d0][r]*rli[r]);}
    asm volatile("s_waitcnt lgkmcnt(0)":::"memory");
    #pragma unroll
    for(int i=0;i<4;++i){const int row=i*8+(lane>>3),ch=lane&7; const u32x4 v=*(const u32x4*)(stg+row*64+ch*8); ATTN_STORE16(Ow+(long)row*DM+ch*8,v);} }
  asm volatile("s_waitcnt lgkmcnt(0)\n\ts_barrier":::"memory");
  #undef DMA_K
  #undef DMA_V
  #undef CMASK
  #undef START
  #undef RESC
  #undef ROT
  #undef LOADB
}
constexpr int ATTN_LDS_BYTES=LDS_BYTES;
#undef SBAR
#undef WAIT_BAR
}
namespace gla {
typedef unsigned short bf16_t;
typedef short bf16x8 __attribute__((ext_vector_type(8)));
typedef short s16x4 __attribute__((ext_vector_type(4)));
typedef float f32x4 __attribute__((ext_vector_type(4)));
typedef float f32x2 __attribute__((ext_vector_type(2)));
typedef float f32x16 __attribute__((ext_vector_type(16)));
typedef unsigned u32x4 __attribute__((ext_vector_type(4)));
typedef unsigned u32x2 __attribute__((ext_vector_type(2)));
#define GLDS __attribute__((address_space(3)))
typedef GLDS unsigned char* ldsp;
constexpr int QT_OFF = 0, QT_RS = 272, KT_OFF = 17408, KH_OFF = 34816, KH_RS = 144, V_OFF = 53248, V_RS = 576, AM_OFF = 90112, AM_RS = 144,
              SEG_OFF = 99328, EBL_OFF = 103424, SSQ_OFF = 103936, W2_OFF = 105984, GV_OFF = 114176, GLA_LDS_BYTES = 115200;
constexpr float SCQ = 0.08838834764831845f;
__device__ __forceinline__ int crow(int r, int hi) { return (r & 3) + 8 * (r >> 2) + 4 * hi; }
__device__ __forceinline__ float bflo(unsigned w) { return __uint_as_float(w << 16); }
__device__ __forceinline__ float bfhi(unsigned w) { return __uint_as_float(w & 0xffff0000u); }
__device__ __forceinline__ unsigned pk(float lo, float hi) { typedef float f2 __attribute__((ext_vector_type(2))); typedef __bf16 b2 __attribute__((ext_vector_type(2))); f2 v = {lo, hi}; b2 b = __builtin_convertvector(v, b2); return __builtin_bit_cast(unsigned, b); }
__device__ __forceinline__ float logsig(float z) { return fminf(z, 0.f) - __logf(1.0f + __expf(-fabsf(z))); }
__device__ __forceinline__ float silu(float x) { return x * __builtin_amdgcn_rcpf(1.0f + __expf(-x)); }
#define GBAR() asm volatile("s_waitcnt lgkmcnt(0)\n\ts_barrier" ::: "memory")
__device__ __forceinline__ s16x4 trrd(ldsp p) { typedef short v4s __attribute__((ext_vector_type(4))); return __builtin_bit_cast(s16x4, __builtin_amdgcn_ds_read_tr16_b64_v4i16((GLDS v4s*)p)); }

template <int MODE> __device__ __forceinline__ void chain(int b, int h, int seg, float* __restrict__ SLOC, float* __restrict__ DTOT, const bf16_t* __restrict__ QB, const bf16_t* __restrict__ KB, const bf16_t* __restrict__ VB, bf16_t* __restrict__ OB, const bf16_t* __restrict__ RB, const float* __restrict__ A1,
                                      const float* __restrict__ w_a2, const float* __restrict__ b_a2, const float* __restrict__ g_gla, float* __restrict__ S_out, char* shm, const int wv) {
    const int tid = TIDX(wv), lane = tid & 63, wid = wv, hi = lane >> 5, r32 = lane & 31;
    const ldsp L = (ldsp)shm;
    GLDS float* W2 = (GLDS float*)(L + W2_OFF); GLDS float* SEG = (GLDS float*)(L + SEG_OFF); GLDS float* EBL = (GLDS float*)(L + EBL_OFF); GLDS float* SSQ = (GLDS float*)(L + SSQ_OFF);
    for (int i = tid; i < 2048; i += 512) W2[i] = w_a2[(i >> 7) * 512 + h * 128 + (i & 127)];
    const int c0 = 2 * lane;
    const float ba0 = b_a2[h * 128 + c0], ba1 = b_a2[h * 128 + c0 + 1];
    GLDS float* GVL = (GLDS float*)(L + GV_OFF);
    if (tid < 256) GVL[tid] = g_gla[h * 256 + tid];
    f32x16 S[4];
#pragma unroll
    for (int i = 0; i < 4; ++i) S[i] = f32x16{};
    const long row00 = (long)b * TSEQ + (long)seg * 1024;
    float dt0 = 0.f, dt1 = 0.f;
    if (MODE == 1) {
        for (int g = 0; g < seg; ++g) { const float* sl = SLOC + ((size_t)((b * 4 + h) * 8 + g) * 128) * 256; const float* dd = DTOT + ((b * 4 + h) * 8 + g) * 128;
#pragma unroll
            for (int cb = 0; cb < 4; ++cb)
#pragma unroll
                for (int r = 0; r < 16; ++r) { const int c = 32 * cb + crow(r, hi); S[cb][r] = __expf(dd[c]) * S[cb][r] + sl[(size_t)c * 256 + 32 * wid + r32]; } }
    }
    unsigned q2[8], k2[8]; float a1r0, a1r1; u32x4 vr[4];
    const unsigned lo4 = (unsigned)lane * 4u, lov = (unsigned)(lane >> 5) * 2048u + (unsigned)(lane & 31) * 16u, lor = (unsigned)r32 * 2048u + (unsigned)hi * 8u;
#define GLA_LOAD(R0) do { const long r0_ = (R0); \
        const char* qu_ = (const char*)(QB + (r0_ + 8 * wid) * 512 + h * 128); const char* ku_ = (const char*)(KB + (r0_ + 8 * wid) * 512 + h * 128); \
        _Pragma("unroll") for (int i = 0; i < 8; ++i) { q2[i] = *(const unsigned*)(qu_ + i * 1024 + lo4); k2[i] = *(const unsigned*)(ku_ + i * 1024 + lo4); } \
        const char* au_ = (const char*)(A1 + (r0_ + 8 * wid) * 16); a1r0 = *(const float*)(au_ + lo4); a1r1 = *(const float*)(au_ + 256 + lo4); \
        const char* vu_ = (const char*)(VB + (r0_ + 2 * wid) * 1024 + h * 256); \
        _Pragma("unroll") for (int j = 0; j < 4; ++j) vr[j] = *(const u32x4*)(vu_ + j * 32768 + lov); } while (0)
    GLA_LOAD(row00);
    GBAR();
    const ldsp vtr0 = L + V_OFF + (8 * hi + ((lane & 15) >> 2)) * V_RS + (32 * wid + 16 * ((lane >> 4) & 1) + 4 * (lane & 3)) * 2;
    for (int n = 0; n < 16; ++n) {
        const long row0 = row00 + 64 * n;
        float bl0[8], bl1[8];
        {
            float z0[8], z1[8];
#pragma unroll
            for (int i = 0; i < 8; ++i) { z0[i] = ba0; z1[i] = ba1; }
#pragma unroll
            for (int r = 0; r < 16; ++r) { const f32x2 w = *(const GLDS f32x2*)(W2 + r * 128 + c0);
#pragma unroll
                for (int i = 0; i < 8; ++i) { const int e = i * 16 + r; const float a = __uint_as_float(__builtin_amdgcn_readlane(__float_as_uint(e < 64 ? a1r0 : a1r1), e & 63)); z0[i] += a * w.x; z1[i] += a * w.y; } }
            float run0 = 0.f, run1 = 0.f;
#pragma unroll
            for (int i = 0; i < 8; ++i) { run0 += logsig(z0[i]) * 0.0625f; run1 += logsig(z1[i]) * 0.0625f; bl0[i] = run0; bl1[i] = run1; }
            *(GLDS f32x2*)(SEG + wid * 128 + c0) = (f32x2){run0, run1};
        }
#pragma unroll
        for (int j = 0; j < 4; ++j) { const int idx = j * 512 + tid; *(GLDS u32x4*)(L + V_OFF + (idx >> 5) * V_RS + (idx & 31) * 16) = vr[j]; }
        GBAR();
        {
            float pre0 = 0.f, pre1 = 0.f, tot0 = 0.f, tot1 = 0.f;
#pragma unroll
            for (int w = 0; w < 8; ++w) { const f32x2 sg = *(const GLDS f32x2*)(SEG + w * 128 + c0); tot0 += sg.x; tot1 += sg.y; if (w < wid) { pre0 += sg.x; pre1 += sg.y; } }
            unsigned kh0[4], kh1[4];
#pragma unroll
            for (int i = 0; i < 8; i += 2) {
                float kx0[2], kx1[2];
#pragma unroll
                for (int d = 0; d < 2; ++d) { const int ii = i + d; const float b0 = pre0 + bl0[ii], b1 = pre1 + bl1[ii];
                    const float qa = bflo(q2[ii]), qb = bfhi(q2[ii]), ka = bflo(k2[ii]), kb = bfhi(k2[ii]);
                    if (MODE == 1) { *(GLDS unsigned*)(L + QT_OFF + (8 * wid + ii) * QT_RS + c0 * 2) = pk(qa * SCQ * __expf(b0), qb * SCQ * __expf(b1));
                    *(GLDS unsigned*)(L + KT_OFF + (8 * wid + ii) * QT_RS + c0 * 2) = pk(ka * __expf(-b0), kb * __expf(-b1)); }
                    kx0[d] = ka * __expf(tot0 - b0); kx1[d] = kb * __expf(tot1 - b1); }
                kh0[i >> 1] = pk(kx0[0], kx0[1]); kh1[i >> 1] = pk(kx1[0], kx1[1]);
            }
            *(GLDS u32x4*)(L + KH_OFF + c0 * KH_RS + wid * 16) = (u32x4){kh0[0], kh0[1], kh0[2], kh0[3]};
            *(GLDS u32x4*)(L + KH_OFF + (c0 + 1) * KH_RS + wid * 16) = (u32x4){kh1[0], kh1[1], kh1[2], kh1[3]};
            if (wid == 0) *(GLDS f32x2*)(EBL + c0) = (f32x2){__expf(tot0), __expf(tot1)};
            dt0 += tot0; dt1 += tot1;
        }
        GBAR();
        if (n + 1 < 16) GLA_LOAD(row0 + 64);
        if (MODE == 1) {
            const int l15 = lane & 15, kq = lane >> 4, tb16 = wid >> 1, sbA = 2 * (wid & 1);
            f32x4 a0 = {0.f, 0.f, 0.f, 0.f}, a1 = {0.f, 0.f, 0.f, 0.f};
#pragma unroll
            for (int kk = 0; kk < 4; ++kk) {
                const bf16x8 qf = *(const GLDS bf16x8*)(L + QT_OFF + (16 * tb16 + l15) * QT_RS + (32 * kk + 8 * kq) * 2);
                const bf16x8 kf0 = *(const GLDS bf16x8*)(L + KT_OFF + (16 * sbA + l15) * QT_RS + (32 * kk + 8 * kq) * 2);
                const bf16x8 kf1 = *(const GLDS bf16x8*)(L + KT_OFF + (16 * sbA + 16 + l15) * QT_RS + (32 * kk + 8 * kq) * 2);
                a0 = __builtin_amdgcn_mfma_f32_16x16x32_bf16(kf0, qf, a0, 0, 0, 0);
                a1 = __builtin_amdgcn_mfma_f32_16x16x32_bf16(kf1, qf, a1, 0, 0, 0);
            }
            const int t = 16 * tb16 + l15, s0 = 16 * sbA + 4 * kq;
#pragma unroll
            for (int i = 0; i < 4; ++i) { if (s0 + i > t) a0[i] = 0.f; if (s0 + 16 + i > t) a1[i] = 0.f; }
            *(GLDS u32x2*)(L + AM_OFF + t * AM_RS + s0 * 2) = (u32x2){pk(a0[0], a0[1]), pk(a0[2], a0[3])};
            *(GLDS u32x2*)(L + AM_OFF + t * AM_RS + (s0 + 16) * 2) = (u32x2){pk(a1[0], a1[1]), pk(a1[2], a1[3])};
        }
        GBAR();
        bf16x8 vf[4];
#pragma unroll
        for (int ks = 0; ks < 4; ++ks) { const s16x4 lo = trrd(vtr0 + ks * 16 * V_RS), hh = trrd(vtr0 + ks * 16 * V_RS + 4 * V_RS); vf[ks] = (bf16x8){lo[0], lo[1], lo[2], lo[3], hh[0], hh[1], hh[2], hh[3]}; }
        f32x16 o[2]; o[0] = f32x16{}; o[1] = f32x16{};
        if (MODE == 1) {
#pragma unroll
        for (int tb = 0; tb < 2; ++tb)
#pragma unroll
            for (int ks = 0; ks < 4; ++ks) { const bf16x8 af = *(const GLDS bf16x8*)(L + AM_OFF + (32 * tb + r32) * AM_RS + (16 * ks + 8 * hi) * 2);
                o[tb] = __builtin_amdgcn_mfma_f32_32x32x16_bf16(vf[ks], af, o[tb], 0, 0, 0); }
        __builtin_amdgcn_sched_barrier(0);
#pragma unroll
        for (int cb = 0; cb < 4; ++cb)
#pragma unroll
            for (int j = 0; j < 2; ++j) {
                const u32x4 sw = {pk(S[cb][8 * j], S[cb][8 * j + 1]), pk(S[cb][8 * j + 2], S[cb][8 * j + 3]), pk(S[cb][8 * j + 4], S[cb][8 * j + 5]), pk(S[cb][8 * j + 6], S[cb][8 * j + 7])};
                const bf16x8 sa = __builtin_bit_cast(bf16x8, sw);
#pragma unroll
                for (int tb = 0; tb < 2; ++tb) { const ldsp qp = L + QT_OFF + (32 * tb + r32) * QT_RS + (32 * cb + 16 * j + 4 * hi) * 2;
                    const u32x2 x0 = *(const GLDS u32x2*)qp, x1 = *(const GLDS u32x2*)(qp + 16);
                    const u32x4 qw = {x0.x, x0.y, x1.x, x1.y};
                    o[tb] = __builtin_amdgcn_mfma_f32_32x32x16_bf16(sa, __builtin_bit_cast(bf16x8, qw), o[tb], 0, 0, 0); }
                __builtin_amdgcn_sched_barrier(0);
            }
        }
#pragma unroll
        for (int cb = 0; cb < 4; ++cb) {
#pragma unroll
            for (int g = 0; g < 4; ++g) { const f32x4 e = *(const GLDS f32x4*)(EBL + 32 * cb + 8 * g + 4 * hi);
                S[cb][4 * g] *= e[0]; S[cb][4 * g + 1] *= e[1]; S[cb][4 * g + 2] *= e[2]; S[cb][4 * g + 3] *= e[3]; }
#pragma unroll
            for (int ks = 0; ks < 4; ++ks) { const bf16x8 kf = *(const GLDS bf16x8*)(L + KH_OFF + (32 * cb + r32) * KH_RS + (16 * ks + 8 * hi) * 2);
                S[cb] = __builtin_amdgcn_mfma_f32_32x32x16_bf16(kf, vf[ks], S[cb], 0, 0, 0); }
            __builtin_amdgcn_sched_barrier(0);
        }
        u32x2 rbv[2][4];
        if (MODE == 1) {
#pragma unroll
        for (int tb = 0; tb < 2; ++tb)
#pragma unroll
            for (int g = 0; g < 4; ++g) rbv[tb][g] = *(const u32x2*)((const char*)(RB + (row0 + 32 * tb) * 1024 + h * 256 + 32 * wid + 8 * g) + lor);
#pragma unroll
        for (int tb = 0; tb < 2; ++tb) { float ss = 0.f;
#pragma unroll
            for (int r = 0; r < 16; ++r) ss += o[tb][r] * o[tb][r];
            ss += __shfl_xor(ss, 32);
            if (hi == 0) SSQ[wid * 64 + 32 * tb + r32] = ss; }
        }
        GBAR();
        if (MODE == 1) {
#pragma unroll
        for (int tb = 0; tb < 2; ++tb) { float tot = 0.f;
#pragma unroll
            for (int w = 0; w < 8; ++w) tot += SSQ[w * 64 + 32 * tb + r32];
            const float rstd = 1.0f / sqrtf(tot * (1.0f / 256.0f) + LN_EPS);
#pragma unroll
            for (int g = 0; g < 4; ++g) { const u32x2 rw = rbv[tb][g];
                const float y0 = o[tb][4 * g] * rstd * bflo(rw.x), y1 = o[tb][4 * g + 1] * rstd * bfhi(rw.x);
                const float y2 = o[tb][4 * g + 2] * rstd * bflo(rw.y), y3 = o[tb][4 * g + 3] * rstd * bfhi(rw.y);
                *(u32x2*)((char*)(OB + (row0 + 32 * tb) * 1024 + h * 256 + 32 * wid + 8 * g) + lor) = (u32x2){pk(y0, y1), pk(y2, y3)}; } }
        }
    }
    if (MODE == 0) {
        float* sl = SLOC + ((size_t)((b * 4 + h) * 8 + seg) * 128) * 256;
#pragma unroll
        for (int cb = 0; cb < 4; ++cb)
#pragma unroll
            for (int r = 0; r < 16; ++r) sl[(size_t)(32 * cb + crow(r, hi)) * 256 + 32 * wid + r32] = S[cb][r];
        if (wid == 0) { float* dd = DTOT + ((b * 4 + h) * 8 + seg) * 128; dd[c0] = dt0; dd[c0 + 1] = dt1; }
    } else if (seg == 7) {
#pragma unroll
        for (int cb = 0; cb < 4; ++cb)
#pragma unroll
            for (int r = 0; r < 16; ++r) S_out[((size_t)(b * 4 + h) * 128 + 32 * cb + crow(r, hi)) * 256 + 32 * wid + r32] = S[cb][r];
    }
    GBAR();
#undef GLA_LOAD
}

__device__ __forceinline__ void sample_unit(int b, int h, const bf16_t* __restrict__ QB, const bf16_t* __restrict__ KB, const bf16_t* __restrict__ VB, bf16_t* __restrict__ OB, const bf16_t* __restrict__ RB, const float* __restrict__ A1,
                                            const float* __restrict__ w_a2, const float* __restrict__ b_a2, const float* __restrict__ g_gla, const float* __restrict__ S0, float* __restrict__ S_out, char* shm, const int wv) {
    const int tid = TIDX(wv), lane = tid & 63, wid = wv;
    GLDS float* Lf = (GLDS float*)shm;
    GLDS float* BQ = Lf; GLDS float* BK = Lf + 2048; GLDS float* KHs = Lf + 4096; GLDS float* EB = Lf + 6144; GLDS float* VL = Lf + 6272; GLDS float* AS = Lf + 10368; GLDS float* SQ = Lf + 10624;
    const long row0 = (long)MP + 16 * b;
    const float* S0h = S0 + (size_t)(b * 4 + h) * 128 * 256; float* SOh = S_out + (size_t)(b * 4 + h) * 128 * 256;
    if (tid < 128) { const int c = tid; float bc[16]; float run = 0.f;
#pragma unroll
        for (int t = 0; t < 16; ++t) { float z = b_a2[h * 128 + c];
#pragma unroll
            for (int r = 0; r < 16; ++r) z += A1[(row0 + t) * 16 + r] * w_a2[r * 512 + h * 128 + c];
            run += logsig(z) * 0.0625f; bc[t] = run; }
#pragma unroll
        for (int t = 0; t < 16; ++t) { const float q = __uint_as_float((unsigned)QB[(row0 + t) * 512 + h * 128 + c] << 16), k = __uint_as_float((unsigned)KB[(row0 + t) * 512 + h * 128 + c] << 16);
            BQ[t * 128 + c] = q * SCQ * __expf(bc[t]); BK[t * 128 + c] = k * __expf(-bc[t]); KHs[t * 128 + c] = k * __expf(run - bc[t]); }
        EB[c] = __expf(run); }
    for (int i = tid; i < 4096; i += 512) VL[i] = __uint_as_float((unsigned)VB[(row0 + (i >> 8)) * 1024 + h * 256 + (i & 255)] << 16);
    __syncthreads();
    if (tid < 256) { const int t = tid >> 4, s = tid & 15; float a = 0.f; if (s <= t) { for (int c = 0; c < 128; ++c) a += BQ[t * 128 + c] * BK[s * 128 + c]; } AS[tid] = a; }
    __syncthreads();
    const int v = tid & 255, th = tid >> 8;
    float o[8];
#pragma unroll
    for (int i = 0; i < 8; ++i) o[i] = 0.f;
    for (int s = 0; s < 16; ++s) { const float vv = VL[s * 256 + v];
#pragma unroll
        for (int i = 0; i < 8; ++i) o[i] += AS[(8 * th + i) * 16 + s] * vv; }
    for (int c = 0; c < 128; ++c) { const float s0 = S0h[c * 256 + v];
#pragma unroll
        for (int i = 0; i < 8; ++i) o[i] += BQ[(8 * th + i) * 128 + c] * s0; }
#pragma unroll
    for (int i = 0; i < 8; ++i) { float ss = o[i] * o[i];
#pragma unroll
        for (int d = 1; d < 64; d <<= 1) ss += __shfl_xor(ss, d);
        if (lane == 0) SQ[(8 * th + i) * 4 + (wid & 3)] = ss; }
    __syncthreads();
#pragma unroll
    for (int i = 0; i < 8; ++i) { const int t = 8 * th + i; const float tot = SQ[t * 4] + SQ[t * 4 + 1] + SQ[t * 4 + 2] + SQ[t * 4 + 3];
        const float rstd = 1.0f / sqrtf(tot * (1.0f / 256.0f) + LN_EPS);
        const float r = __uint_as_float((unsigned)RB[(row0 + t) * 1024 + h * 256 + v] << 16);
        const float y = o[i] * rstd * r;
        OB[(row0 + t) * 1024 + h * 256 + v] = (bf16_t)(pk(y, 0.f) & 0xffffu); }
    for (int cc = 0; cc < 64; ++cc) { const int c = 64 * th + cc; float s = EB[c] * S0h[c * 256 + v];
#pragma unroll
        for (int t = 0; t < 16; ++t) s += KHs[t * 128 + c] * VL[t * 256 + v];
        SOh[c * 256 + v] = s; }
    __syncthreads();
}
#undef GBAR
}
namespace sattn {
typedef unsigned short bf16_t;
typedef short bf16x8 __attribute__((ext_vector_type(8)));
typedef float f32x4 __attribute__((ext_vector_type(4)));
typedef unsigned u32x4 __attribute__((ext_vector_type(4)));
#define SLDS __attribute__((address_space(3)))
constexpr int PAST = 2048, NKEY = 2064, NBLK = 65;
__device__ __forceinline__ unsigned pk(float lo, float hi) { return gla::pk(lo, hi); }
__device__ __forceinline__ void unit(int b, int h, const bf16_t* __restrict__ QA, bf16_t* OA, const float* __restrict__ cK, const float* __restrict__ cV, const float* __restrict__ cF,
                                     const float* __restrict__ out, char* shm, const int wv) {
    const int tid = TIDX(wv), lane = tid & 63, wid = wv, l15 = lane & 15, kq = lane >> 4;
    SLDS float* CB = (SLDS float*)shm;
    SLDS float* CM = CB + 2600;
    {
        const int j0 = 5 * tid; float sv[5]; float run = 0.f;
#pragma unroll
        for (int i = 0; i < 5; ++i) { const int j = j0 + i; float lf = 0.f;
            if (j < PAST) lf = cF[((size_t)b * PAST + j) * 8 + h]; else if (j < NKEY) lf = out[O_FS + ((size_t)b * 16 + (j - PAST)) * 8 + h];
            run += lf; sv[i] = run; }
        float incl = run;
#pragma unroll
        for (int o_ = 1; o_ < 64; o_ <<= 1) { const float n_ = __shfl_up(incl, o_); if (lane >= o_) incl += n_; }
        if (lane == 63) CB[2560 + wid] = incl;
        __syncthreads();
        float wp = 0.f;
#pragma unroll
        for (int w_ = 0; w_ < 8; ++w_) { const float x_ = CB[2560 + w_]; if (w_ < wid) wp += x_; }
        const float off_ = wp + incl - run;
#pragma unroll
        for (int i = 0; i < 5; ++i) CB[j0 + i] = -(off_ + sv[i]) * 1.4426950408889634f;
        __syncthreads();
    }
    const long qrow = (long)MP + 16 * b + l15;
    const bf16x8 qf0 = *(const bf16x8*)(QA + qrow * 512 + h * 64 + 8 * kq), qf1 = *(const bf16x8*)(QA + qrow * 512 + h * 64 + 32 + 8 * kq);
    float m_run = -1e30f, l_run = 0.f; f32x4 O[4];
#pragma unroll
    for (int i = 0; i < 4; ++i) O[i] = (f32x4){0.f, 0.f, 0.f, 0.f};
    for (int blk = wid; blk < NBLK; blk += 8) {
        const int key0 = 32 * blk;
        f32x4 st[2];
#pragma unroll
        for (int e = 0; e < 2; ++e) { int key = key0 + 16 * e + l15; if (key > NKEY - 1) key = NKEY - 1;
            const float* kp = key < PAST ? cK + (((size_t)b * PAST + key) * 8 + h) * 64 : out + O_KS + (((size_t)b * 16 + (key - PAST)) * 8 + h) * 64;
            const f32x4 a0 = *(const f32x4*)(kp + 8 * kq), a1 = *(const f32x4*)(kp + 8 * kq + 4), a2 = *(const f32x4*)(kp + 32 + 8 * kq), a3 = *(const f32x4*)(kp + 32 + 8 * kq + 4);
            const u32x4 w0 = {pk(a0[0], a0[1]), pk(a0[2], a0[3]), pk(a1[0], a1[1]), pk(a1[2], a1[3])}, w1 = {pk(a2[0], a2[1]), pk(a2[2], a2[3]), pk(a3[0], a3[1]), pk(a3[2], a3[3])};
            f32x4 s = {0.f, 0.f, 0.f, 0.f};
            s = __builtin_amdgcn_mfma_f32_16x16x32_bf16(__builtin_bit_cast(bf16x8, w0), qf0, s, 0, 0, 0);
            s = __builtin_amdgcn_mfma_f32_16x16x32_bf16(__builtin_bit_cast(bf16x8, w1), qf1, s, 0, 0, 0);
            st[e] = s; }
        float mx = -1e30f;
#pragma unroll
        for (int e = 0; e < 2; ++e)
#pragma unroll
            for (int i = 0; i < 4; ++i) { const int key = key0 + 16 * e + 4 * kq + i; float v = st[e][i] + CB[key]; if (key - PAST > l15) v = -1e30f; st[e][i] = v; mx = fmaxf(mx, v); }
        mx = fmaxf(mx, __shfl_xor(mx, 16)); mx = fmaxf(mx, __shfl_xor(mx, 32));
        const float mnew = fmaxf(m_run, mx), f = exp2f(m_run - mnew); m_run = mnew;
        float ps = 0.f; float p[2][4];
#pragma unroll
        for (int e = 0; e < 2; ++e)
#pragma unroll
            for (int i = 0; i < 4; ++i) { const float pv = (st[e][i] <= -1e29f) ? 0.f : exp2f(st[e][i] - mnew); p[e][i] = pv; ps += pv; }
        l_run = l_run * f + ps;
#pragma unroll
        for (int d = 0; d < 4; ++d) O[d] *= f;
        const u32x4 pw = {pk(p[0][0], p[0][1]), pk(p[0][2], p[0][3]), pk(p[1][0], p[1][1]), pk(p[1][2], p[1][3])};
        const bf16x8 pB = __builtin_bit_cast(bf16x8, pw);
        float vv[4][8];
#pragma unroll
        for (int sl = 0; sl < 8; ++sl) { int key = key0 + 16 * (sl >> 2) + 4 * kq + (sl & 3); if (key > NKEY - 1) key = NKEY - 1;
            const float* vp = key < PAST ? cV + (((size_t)b * PAST + key) * 8 + h) * 64 : out + O_VS + (((size_t)b * 16 + (key - PAST)) * 8 + h) * 64;
#pragma unroll
            for (int db = 0; db < 4; ++db) vv[db][sl] = vp[16 * db + l15]; }
#pragma unroll
        for (int db = 0; db < 4; ++db) { const u32x4 vw = {pk(vv[db][0], vv[db][1]), pk(vv[db][2], vv[db][3]), pk(vv[db][4], vv[db][5]), pk(vv[db][6], vv[db][7])};
            O[db] = __builtin_amdgcn_mfma_f32_16x16x32_bf16(__builtin_bit_cast(bf16x8, vw), pB, O[db], 0, 0, 0); }
    }
    l_run += __shfl_xor(l_run, 16); l_run += __shfl_xor(l_run, 32);
    SLDS float* cw = CM + wid * 1056;
    if (kq == 0) { cw[l15] = m_run; cw[16 + l15] = l_run; }
#pragma unroll
    for (int db = 0; db < 4; ++db)
#pragma unroll
        for (int i = 0; i < 4; ++i) cw[32 + (16 * db + 4 * kq + i) * 16 + l15] = O[db][i];
    __syncthreads();
    { const int q = tid >> 5, d0 = 2 * (tid & 31);
        float M = -1e30f;
#pragma unroll
        for (int w = 0; w < 8; ++w) M = fmaxf(M, CM[w * 1056 + q]);
        float Ls = 0.f, o0 = 0.f, o1 = 0.f;
#pragma unroll
        for (int w = 0; w < 8; ++w) { const float sc = exp2f(CM[w * 1056 + q] - M); Ls += CM[w * 1056 + 16 + q] * sc; o0 += CM[w * 1056 + 32 + d0 * 16 + q] * sc; o1 += CM[w * 1056 + 32 + (d0 + 1) * 16 + q] * sc; }
        const float inv = 1.0f / Ls;
        *(unsigned*)(OA + ((long)MP + 16 * b + q) * 512 + h * 64 + d0) = pk(o0 * inv, o1 * inv); }
    __syncthreads();
}
}
namespace cg = cooperative_groups;
typedef unsigned short bf16;
#define LAS __attribute__((address_space(3)))
typedef unsigned v4u __attribute__((ext_vector_type(4)));
typedef float f32x4 __attribute__((ext_vector_type(4)));
constexpr size_t MiB = 1u << 20;
constexpr size_t WS_CTL = 0, WS_WIN = 1 * MiB, WS_WAO = 15 * MiB, WS_WBO = 16 * MiB, WS_WO = 18 * MiB, WS_WUP = 20 * MiB, WS_WDN = 31 * MiB, WS_WPLG = 37 * MiB, WS_WPL = 39 * MiB, WS_A1 = 40 * MiB, WS_CBG = 45 * MiB;
constexpr size_t WS_XB = 48 * MiB;
constexpr size_t WS_QA = 177 * MiB, WS_KA = 242 * MiB, WS_VA = 307 * MiB, WS_QB = 372 * MiB, WS_KB = 437 * MiB, WS_VB = 502 * MiB, WS_RB = 631 * MiB, WS_GB = 760 * MiB, WS_PB = 889 * MiB;
constexpr size_t WS_OA = 922 * MiB, WS_SLOC = 988 * MiB, WS_DTOT = 1020 * MiB;
constexpr size_t WS_UP = 177 * MiB, WS_H = 531 * MiB, WS_ZB = 177 * MiB, WS_TMP = 307 * MiB;
constexpr int RING_BYTES = 131072, MISC_OFF = RING_BYTES + 320, LDS_BYTES = 147456;
static_assert(attn_body::ATTN_LDS_BYTES <= RING_BYTES && gla::GLA_LDS_BYTES <= RING_BYTES, "phase scratch fits the ring");

__device__ __forceinline__ unsigned f2bf(float f) { unsigned u = __builtin_bit_cast(unsigned, f); return (u + 0x7fffu + ((u >> 16) & 1u)) >> 16; }
__device__ __forceinline__ unsigned pk2(float lo, float hi) { return f2bf(lo) | (f2bf(hi) << 16); }
__device__ __forceinline__ float wave_sum(float v) {
#pragma unroll
    for (int o = 1; o < 64; o <<= 1) v += __shfl_xor(v, o);
    return v;
}
__device__ __forceinline__ int map_win(int d) {
    if (d < 1536) return d;
    if (d < 2560) return 1544 + (d - 1536);
    if (d < 3584) return 2568 + (d - 2560);
    if (d < 4608) return 3592 + (d - 3584);
    if (d < 5632) return 4632 + (d - 4608);
    if (d < 6656) return 5656 + (d - 5632);
    if (d < 6664) return 1536 + (d - 6656);
    if (d < 6680) return 4616 + (d - 6664);
    return -1;
}
__device__ __forceinline__ int map_wup(int d) { const int j = d >> 8, l = d & 255; return l < 128 ? 128 * j + l : DFF + 128 * j + (l - 128); }
template <int MAP> __device__ __forceinline__ void transpose_item(const float* W, int K, int N, bf16* WT, LAS float* scr, int item, int nblk, int lane) {
    const int kb = item / nblk, nb = item % nblk, k0 = 64 * kb, n0 = 32 * nb;
    const int d = n0 + (lane & 31); const int sc = MAP == 1 ? map_win(d) : MAP == 2 ? map_wup(d) : d;
#pragma unroll 8
    for (int i = 0; i < 32; ++i) { const int kk = 2 * i + (lane >> 5); scr[kk * 33 + (lane & 31)] = sc >= 0 ? W[(size_t)(k0 + kk) * N + sc] : 0.f; }
    asm volatile("s_waitcnt lgkmcnt(0)" ::: "memory");
    const int c = lane & 7;
#pragma unroll
    for (int j = 0; j < 4; ++j) { const int n = (lane >> 3) + 8 * j; const LAS float* s = scr + (8 * c) * 33 + n;
        v4u o; o.x = pk2(s[0 * 33], s[1 * 33]); o.y = pk2(s[2 * 33], s[3 * 33]); o.z = pk2(s[4 * 33], s[5 * 33]); o.w = pk2(s[6 * 33], s[7 * 33]);
        *(v4u*)(WT + (size_t)(n0 + n) * K + k0 + 8 * c) = o; }
    asm volatile("s_waitcnt lgkmcnt(0)" ::: "memory");
}
template <int NR> __device__ __forceinline__ void ln_rows(const bf16* (&zr)[NR], bf16* (&ob)[NR], float* (&of)[NR], const float* g, const float* bt, int lane) {
    f32x4 v[NR][4];
#pragma unroll
    for (int r = 0; r < NR; ++r) { const v4u w0 = __builtin_nontemporal_load((const v4u*)zr[r] + lane), w1 = __builtin_nontemporal_load((const v4u*)zr[r] + 64 + lane); epi::unpack8(w0, v[r][0], v[r][1]); epi::unpack8(w1, v[r][2], v[r][3]); }
    f32x4 gg[4], bb[4];
#pragma unroll
    for (int j = 0; j < 4; ++j) { gg[j] = *((const f32x4*)g + (j >> 1) * 128 + 2 * lane + (j & 1)); bb[j] = *((const f32x4*)bt + (j >> 1) * 128 + 2 * lane + (j & 1)); }
#pragma unroll
    for (int r = 0; r < NR; ++r) { float s = 0.f;
#pragma unroll
        for (int j = 0; j < 4; ++j) s += (v[r][j].x + v[r][j].y) + (v[r][j].z + v[r][j].w);
        const float mean = wave_sum(s) * (1.f / 1024.f); float s2 = 0.f;
#pragma unroll
        for (int j = 0; j < 4; ++j) { v[r][j] = v[r][j] - mean; s2 += (v[r][j].x * v[r][j].x + v[r][j].y * v[r][j].y) + (v[r][j].z * v[r][j].z + v[r][j].w * v[r][j].w); }
        const float rstd = 1.f / sqrtf(wave_sum(s2) * (1.f / 1024.f) + LN_EPS);
#pragma unroll
        for (int j = 0; j < 4; ++j) v[r][j] = v[r][j] * rstd * gg[j] + bb[j];
        if (ob[r]) { *((v4u*)ob[r] + lane) = epi::pack8(v[r][0], v[r][1]); *((v4u*)ob[r] + 64 + lane) = epi::pack8(v[r][2], v[r][3]); }
        if (of[r]) { f32x4* o = (f32x4*)of[r]; __builtin_nontemporal_store(v[r][0], o + 2 * lane); __builtin_nontemporal_store(v[r][1], o + 2 * lane + 1); __builtin_nontemporal_store(v[r][2], o + 128 + 2 * lane); __builtin_nontemporal_store(v[r][3], o + 128 + 2 * lane + 1); } }
}
__device__ __forceinline__ void ln_phase(const bf16* Z, bf16* OB, float* OF, const float* g, const float* bt, int gw, int NGW, int lane) {
    for (int m = gw; m < MROWS; m += 4 * NGW) {
        if (m + 3 * NGW < MROWS) { const bf16* zr[4]; bf16* ob[4]; float* of[4];
#pragma unroll
            for (int r = 0; r < 4; ++r) { const size_t o = (size_t)(m + r * NGW) * 1024; zr[r] = Z + o; ob[r] = OB ? OB + o : nullptr; of[r] = OF ? OF + o : nullptr; }
            ln_rows<4>(zr, ob, of, g, bt, lane); }
        else { for (int r = 0; r < 4; ++r) { const int mm = m + r * NGW; if (mm < MROWS) { const bf16* zr[1] = {Z + (size_t)mm * 1024}; bf16* ob[1] = {OB ? OB + (size_t)mm * 1024 : nullptr}; float* of[1] = {OF ? OF + (size_t)mm * 1024 : nullptr}; ln_rows<1>(zr, ob, of, g, bt, lane); } } } }
}
__device__ __forceinline__ float gelu_tanh(float x) { const float u = 0.7978845608028654f * (x + 0.044715f * x * x * x); const float e = __expf(2.f * u); return 0.5f * x * (2.f - 2.f * __builtin_amdgcn_rcpf(1.f + e)); }
__device__ __forceinline__ void conv_phase(const bf16* __restrict__ UP, bf16* __restrict__ H, const float* __restrict__ cw, const float* __restrict__ cbias, const float* __restrict__ cprev, int half, int gw, int NGW, int lane) {
    const int cgp = lane & 15, rs = lane >> 4;
    for (int it = gw; it < (MROWS / 64) * 11; it += NGW) {
        const int jl = it % 11, run = it / 11, jg = half * 11 + jl, r0 = run * 64 + 16 * rs;
        const int colv = 128 * jg + 8 * cgp, colg = DFF + colv;
        float w0v[8], w1v[8], w2v[8], bv[8], w0g[8], w1g[8], w2g[8], bg[8];
#pragma unroll
        for (int i = 0; i < 8; ++i) { w0v[i] = cw[colv + i]; w1v[i] = cw[5632 + colv + i]; w2v[i] = cw[2 * 5632 + colv + i]; bv[i] = cbias[colv + i];
            w0g[i] = cw[colg + i]; w1g[i] = cw[5632 + colg + i]; w2g[i] = cw[2 * 5632 + colg + i]; bg[i] = cbias[colg + i]; }
        float v2[8], v1[8], g2[8], g1[8];
        const bf16* up = UP + (size_t)r0 * DFF + 256 * jl + 8 * cgp;
        if (r0 < MP && (r0 & (TSEQ - 1)) != 0) { f32x4 a, b;
            epi::unpack8(*(const v4u*)(up - 2 * DFF), a, b); v2[0] = a[0]; v2[1] = a[1]; v2[2] = a[2]; v2[3] = a[3]; v2[4] = b[0]; v2[5] = b[1]; v2[6] = b[2]; v2[7] = b[3];
            epi::unpack8(*(const v4u*)(up - DFF), a, b); v1[0] = a[0]; v1[1] = a[1]; v1[2] = a[2]; v1[3] = a[3]; v1[4] = b[0]; v1[5] = b[1]; v1[6] = b[2]; v1[7] = b[3];
            epi::unpack8(*(const v4u*)(up - 2 * DFF + 128), a, b); g2[0] = a[0]; g2[1] = a[1]; g2[2] = a[2]; g2[3] = a[3]; g2[4] = b[0]; g2[5] = b[1]; g2[6] = b[2]; g2[7] = b[3];
            epi::unpack8(*(const v4u*)(up - DFF + 128), a, b); g1[0] = a[0]; g1[1] = a[1]; g1[2] = a[2]; g1[3] = a[3]; g1[4] = b[0]; g1[5] = b[1]; g1[6] = b[2]; g1[7] = b[3];
        } else if (r0 >= MP) { const float* cp = cprev + (size_t)((r0 - MP) >> 4) * 2 * 5632;
#pragma unroll
            for (int i = 0; i < 8; ++i) { v2[i] = cp[colv + i]; v1[i] = cp[5632 + colv + i]; g2[i] = cp[colg + i]; g1[i] = cp[5632 + colg + i]; }
        } else {
#pragma unroll
            for (int i = 0; i < 8; ++i) { v2[i] = 0.f; v1[i] = 0.f; g2[i] = 0.f; g1[i] = 0.f; }
        }
        bf16* hp = H + (size_t)r0 * DFF + colv;
#pragma unroll 4
        for (int t = 0; t < 16; ++t) { f32x4 a, b, c, d; epi::unpack8(__builtin_nontemporal_load((const v4u*)(up + (size_t)t * DFF)), a, b); epi::unpack8(__builtin_nontemporal_load((const v4u*)(up + (size_t)t * DFF + 128)), c, d);
            const float cv[8] = {a[0], a[1], a[2], a[3], b[0], b[1], b[2], b[3]}, cgt[8] = {c[0], c[1], c[2], c[3], d[0], d[1], d[2], d[3]};
            float o[8];
#pragma unroll
            for (int i = 0; i < 8; ++i) { const float val = bv[i] + w0v[i] * v2[i] + w1v[i] * v1[i] + w2v[i] * cv[i]; const float gt = bg[i] + w0g[i] * g2[i] + w1g[i] * g1[i] + w2g[i] * cgt[i];
                o[i] = val * gelu_tanh(gt); v2[i] = v1[i]; v1[i] = cv[i]; g2[i] = g1[i]; g1[i] = cgt[i]; }
            v4u w; w.x = pk2(o[0], o[1]); w.y = pk2(o[2], o[3]); w.z = pk2(o[4], o[5]); w.w = pk2(o[6], o[7]);
            __builtin_nontemporal_store(w, (v4u*)(hp + (size_t)t * DFF)); }
    }
}

#define XB_TMO      128
#define XB_XCNT(j)  (256  + 64 * (j))
#define XB_XSUB(j)  (1280 + 64 * (j))
#define XB_XGEN(j)  (2304 + 64 * (j))
#define XB_TOP      3328
#define XB_TOPGEN   3392
#define XCD_BAR_WORDS 3456
#define XB_SPIN_CAP (1u << 18)

__device__ __forceinline__ unsigned xb_ld(unsigned* p)              { return __hip_atomic_load(p, __ATOMIC_RELAXED, __HIP_MEMORY_SCOPE_AGENT); }
__device__ __forceinline__ unsigned xb_add(unsigned* p, unsigned v) { return __hip_atomic_fetch_add(p, v, __ATOMIC_RELAXED, __HIP_MEMORY_SCOPE_AGENT); }
__device__ __forceinline__ unsigned xb_xcc_id() { return (unsigned)__builtin_amdgcn_s_getreg((3 << 11) | 20) & 0xFu; }
#define XB_SPIN(cond, bar) do { unsigned _sp = 0; while (cond) { __builtin_amdgcn_s_sleep(1); \
    if ((++_sp & 255u) == 0u) { if (xb_ld(&(bar)[XB_TMO])) break; if (_sp > XB_SPIN_CAP) { atomicAdd(&(bar)[XB_TMO], 1u); break; } } } } while (0)

struct XcdBarrier {
    unsigned* bar; unsigned x;
    volatile LAS unsigned* st;
};

__device__ __forceinline__ XcdBarrier xcd_barrier_post(unsigned* bar, volatile LAS unsigned* st, bool t0) {
    XcdBarrier b; b.bar = bar; b.x = xb_xcc_id(); b.st = st;
    if (t0) (void)xb_add(&bar[XB_XCNT(b.x)], 1u);
    return b;
}
__device__ __forceinline__ void xcd_barrier_complete(unsigned* bar, unsigned x, unsigned& nloc, unsigned& nx) {
    const unsigned G = gridDim.x * gridDim.y * gridDim.z;
    unsigned sum, cnt, mine, sp = 0u;
    for (;;) {
        sum = 0u; cnt = 0u; mine = 0u;
#pragma unroll
        for (unsigned j = 0; j < 16; ++j) { const unsigned c = xb_ld(&bar[XB_XCNT(j)]); sum += c; cnt += (c > 0u) ? 1u : 0u; mine = (j == x) ? c : mine; }
        if (sum == G) break;
        __builtin_amdgcn_s_sleep(1);
        if ((++sp & 255u) == 0u) { if (xb_ld(&bar[XB_TMO])) break; if (sp > XB_SPIN_CAP) { atomicAdd(&bar[XB_TMO], 1u); break; } }
    }
    nloc = mine > 0u ? mine : 1u; nx = cnt > 0u ? cnt : 1u;
}

__device__ __forceinline__ void xcd_barrier(const XcdBarrier& b, bool t0) {
    asm volatile("s_waitcnt vmcnt(0)" ::: "memory");
    __syncthreads();
    if (t0) {
        unsigned* bar = b.bar;
        __builtin_amdgcn_s_waitcnt(0);
        unsigned nloc = b.st[0], nx = b.st[1];
        if (nloc == 0u) { xcd_barrier_complete(bar, b.x, nloc, nx); b.st[0] = nloc; b.st[1] = nx; }
        const unsigned old = xb_add(&bar[XB_XSUB(b.x)], 1u);
        const unsigned gen = old / nloc;
        if (old + 1u == (gen + 1u) * nloc) {
            __builtin_amdgcn_fence(__ATOMIC_RELEASE, "agent");
            asm volatile("s_waitcnt vmcnt(0)" ::: "memory");
            const unsigned og = xb_add(&bar[XB_TOP], 1u);
            const unsigned tg = og / nx;
            if (og + 1u == (tg + 1u) * nx) xb_add(&bar[XB_TOPGEN], 1u);
            else XB_SPIN(xb_ld(&bar[XB_TOPGEN]) == tg, bar);
            __builtin_amdgcn_fence(__ATOMIC_ACQUIRE, "agent");
            xb_add(&bar[XB_XGEN(b.x)], 1u);
            asm volatile("s_waitcnt vmcnt(0)" ::: "memory");
        } else {
            XB_SPIN(xb_ld(&bar[XB_XGEN(b.x)]) == gen, bar);
            __builtin_amdgcn_fence(__ATOMIC_ACQUIRE, "agent");
            asm volatile("s_waitcnt vmcnt(0)" ::: "memory");
        }
    }
    __syncthreads();
}

struct Args { const float* in[29]; float* out; unsigned char* ws; int ph_lo, ph_hi; };
#define KAS __attribute__((address_space(4)))
__device__ __forceinline__ const float* karg(int i) { const KAS char* ka = (const KAS char*)__builtin_amdgcn_kernarg_segment_ptr(); const unsigned long long v = *(const unsigned long long volatile KAS*)(ka + 8 * i); return (const float*)(const __attribute__((address_space(1))) float*)v; }
__device__ __forceinline__ int kargi(int byteoff) { const KAS char* ka = (const KAS char*)__builtin_amdgcn_kernarg_segment_ptr(); return *(const int volatile KAS*)(ka + byteoff); }
constexpr int N_PHASES = 14;
__global__ void __launch_bounds__(512, 2) fwd_kernel(Args args) {
    extern __shared__ __attribute__((aligned(16))) unsigned char lds[];
    LAS unsigned char* ldsl = (LAS unsigned char*)lds;
    volatile LAS unsigned* MISC = (volatile LAS unsigned*)(ldsl + MISC_OFF);
    const int wave = __builtin_amdgcn_readfirstlane((int)threadIdx.x >> 6);
#define lane lane_id_asm()
#define tid TIDX(wave)
    const int G = gridDim.x, bx = blockIdx.x; const int vcu = (G % 8 == 0) ? (bx % 8) * (G / 8) + bx / 8 : bx;
    const int gw = vcu * 8 + wave, NGW = G * 8;
    if (TIDX(wave) < 32) MISC[TIDX(wave)] = 0u;
    __syncthreads();
    XcdBarrier xbar = xcd_barrier_post((unsigned*)(karg(30)) + 4096, MISC + 8, TIDX(wave) == 0);
#define GSYNC() xcd_barrier(xbar, TIDX(wave) == 0)
#define x_p karg(0)
#define x_s karg(1)
#define cK karg(2)
#define cV karg(3)
#define cF karg(4)
#define S0 karg(5)
#define cconv karg(6)
#define p_p karg(7)
#define p_s karg(8)
#define w_in karg(9)
#define b_fg karg(10)
#define w_a2 karg(11)
#define b_a2 karg(12)
#define g_gla karg(13)
#define w_ao karg(14)
#define w_bo karg(15)
#define w_o karg(16)
#define ln1g karg(17)
#define ln1b karg(18)
#define w_up karg(19)
#define conv_w karg(20)
#define conv_b karg(21)
#define w_dn karg(22)
#define ln2g karg(23)
#define ln2b karg(24)
#define w_pl karg(25)
#define w_plg karg(26)
#define ln3g karg(27)
#define ln3b karg(28)
#define out ((float*)karg(29))
#define ws ((unsigned char*)karg(30))
#define Win ((bf16*)(ws + WS_WIN))
#define Wao ((bf16*)(ws + WS_WAO))
#define Wbo ((bf16*)(ws + WS_WBO))
#define Wo ((bf16*)(ws + WS_WO))
#define Wup ((bf16*)(ws + WS_WUP))
#define Wdn ((bf16*)(ws + WS_WDN))
#define Wplg ((bf16*)(ws + WS_WPLG))
#define Wpl ((bf16*)(ws + WS_WPL))
#define A1 ((float*)(ws + WS_A1))
#define XB ((bf16*)(ws + WS_XB))
#define QA ((bf16*)(ws + WS_QA))
#define KA ((bf16*)(ws + WS_KA))
#define VA ((bf16*)(ws + WS_VA))
#define QB ((bf16*)(ws + WS_QB))
#define KB ((bf16*)(ws + WS_KB))
#define VB ((bf16*)(ws + WS_VB))
#define RB ((bf16*)(ws + WS_RB))
#define GB ((bf16*)(ws + WS_GB))
#define PB ((bf16*)(ws + WS_PB))
#define OA ((bf16*)(ws + WS_OA))
#define OBG XB
#define MG VB
#define GA ((bf16*)out)
#define UP ((bf16*)(ws + WS_UP))
#define HB ((bf16*)(ws + WS_H))
#define TMP ((bf16*)(ws + WS_TMP))
#define ZB ((bf16*)(ws + WS_ZB))
#define Y (out + O_Y)
    const int lo = kargi(31 * 8), hi = kargi(31 * 8 + 4);
#ifndef PH_MASK
#define PH_MASK 0xffff
#endif
#define IN(k) (((PH_MASK >> (k)) & 1) && lo <= (k) && (k) < hi)
#ifndef REPEAT_MASK
#define REPEAT_MASK 0
#endif
#define NREP(k) ((((REPEAT_MASK) >> (k)) & 1) + 1)
#define SEAM(k) do { if (IN(k) && IN((k) + 1)) { if ((k) == 0) cg::this_grid().sync(); else GSYNC(); } } while (0)

    for (int rep = 0; rep < NREP(0); ++rep) if (IN(0)) {
        LAS float* scr = (LAS float*)(ldsl + wave * 16384);
        constexpr int I0 = 16 * 216, I1 = 8 * 32, I2 = 16 * 32, I3 = 16 * 32, I4 = 16 * 32, I5 = 16 * 176, I6 = 44 * 32, I7 = 4 * 32;
        constexpr int NIT = I0 + I1 + I2 + I3 + I4 + I5 + I6 + I7;
        for (int it = gw; it < NIT; it += NGW) {
            int r = it;
            if (r < I0) { transpose_item<1>(w_in, 1024, 6680, Win, scr, r, 216, lane); continue; } r -= I0;
            if (r < I1) { transpose_item<0>(w_ao, 512, 1024, Wao, scr, r, 32, lane); continue; } r -= I1;
            if (r < I2) { transpose_item<0>(w_bo, 1024, 1024, Wbo, scr, r, 32, lane); continue; } r -= I2;
            if (r < I3) { transpose_item<0>(w_o, 1024, 1024, Wo, scr, r, 32, lane); continue; } r -= I3;
            if (r < I4) { transpose_item<0>(w_plg, 1024, 1024, Wplg, scr, r, 32, lane); continue; } r -= I4;
            if (r < I5) { transpose_item<2>(w_up, 1024, 5632, Wup, scr, r, 176, lane); continue; } r -= I5;
            if (r < I6) { transpose_item<0>(w_dn, 2816, 1024, Wdn, scr, r, 32, lane); continue; } r -= I6;
            transpose_item<0>(w_pl, 256, 1024, Wpl, scr, r, 32, lane);
        }
        for (int m0 = gw; m0 < MROWS; m0 += 4 * NGW) {
            f32x4 v[4][4], pv[4];
#pragma unroll
            for (int r = 0; r < 4; ++r) { const int m = m0 + r * NGW; if (m < MROWS) {
                const float* xr = m < MP ? x_p + (size_t)m * 1024 : x_s + (size_t)(m - MP) * 1024; const float* pr = m < MP ? p_p + (size_t)m * 256 : p_s + (size_t)(m - MP) * 256;
#pragma unroll
                for (int j = 0; j < 4; ++j) v[r][j] = __builtin_nontemporal_load((const f32x4*)xr + lane + 64 * j);
                pv[r] = __builtin_nontemporal_load((const f32x4*)pr + lane); } }
#pragma unroll
            for (int r = 0; r < 4; ++r) { const int m = m0 + r * NGW; if (m < MROWS) {
                unsigned long long* o8 = (unsigned long long*)(XB + (size_t)m * 1024) + lane;
#pragma unroll
                for (int j = 0; j < 4; ++j) o8[64 * j] = (unsigned long long)pk2(v[r][j].x, v[r][j].y) | ((unsigned long long)pk2(v[r][j].z, v[r][j].w) << 32);
                *((unsigned long long*)(PB + (size_t)m * 256) + lane) = (unsigned long long)pk2(pv[r].x, pv[r].y) | ((unsigned long long)pk2(pv[r].z, pv[r].w) << 32); } }
        }
    }
    SEAM(0);
#ifdef EXTRA_SYNCS
    for (int e_ = 0; e_ < EXTRA_SYNCS; ++e_) GSYNC();
#endif
    for (int rep = 0; rep < NREP(1); ++rep) if (IN(1)) {
        pg8::Gemm g{XB, Win, MP, 6912, 1024}; pg8::StaticOrder S; S.init(MP, 6912, G, bx);
        epi::EpiProj E{QA, KA, VA, QB, KB, VB, RB, GA, GB, A1, out, b_fg, (unsigned*)(ws + WS_CTL) + 128, g_gla};
        epi::light_gemm_wide(XB, Win, 6912, 1024, E, wave, bx, G, ldsl);
        pg8::gemm_phase<epi::EpiProj, pg8::StaticOrder, true, true>(ldsl, g, S, E, wave);
    }
    SEAM(1);
    for (int rep = 0; rep < NREP(2); ++rep) { if (rep) GSYNC(); if (IN(2)) {
#ifndef MIX_MASK
#define MIX_MASK 15
#endif
#ifndef REP2_MIX
#define REP2_MIX 15
#endif
        const int mixm = rep ? (REP2_MIX) : (MIX_MASK);
        if (mixm & 2) { for (int c = bx; c < 64; c += G) attn_body::cb_scan(c >> 3, c & 7, out + O_FP, (float*)(ws + WS_CBG), (char*)lds, wave); }
        if (mixm & 1) {
            for (int it = bx; it < 224; it += G) gla::chain<0>((it & 31) >> 2, it & 3, it >> 5, (float*)(ws + WS_SLOC), (float*)(ws + WS_DTOT), QB, KB, VB, OBG, RB, A1, w_a2, b_a2, g_gla, out + O_SP, (char*)lds, wave);
            if (bx >= 224 || G < 256) {
                const int nb = G < 256 ? G : G - 224, b0 = G < 256 ? bx : bx - 224;
                if (mixm & 4) { for (int u = b0; u < 64; u += nb) sattn::unit(u >> 3, u & 7, QA, OA, cK, cV, cF, out, (char*)lds, wave); }
                if (mixm & 8) { for (int u = b0; u < 32; u += nb) gla::sample_unit(u >> 2, u & 3, QB, KB, VB, OBG, RB, A1, w_a2, b_a2, g_gla, S0, out + O_SS, (char*)lds, wave); } }
            GSYNC();
            for (int it = bx; it < 256; it += G) gla::chain<1>((it & 31) >> 2, it & 3, it >> 5, (float*)(ws + WS_SLOC), (float*)(ws + WS_DTOT), QB, KB, VB, OBG, RB, A1, w_a2, b_a2, g_gla, out + O_SP, (char*)lds, wave); }
        if (mixm & 2) { unsigned* qctr = (unsigned*)(ws + WS_CTL) + 64 * rep;
            const attn_body::bf16 *qa_ = (const attn_body::bf16*)QA, *ka_ = (const attn_body::bf16*)KA, *va_ = (const attn_body::bf16*)VA; const float* lf_ = (const float*)(ws + WS_CBG);
            for (;;) {
                if (tid == 0) MISC[0] = atomicAdd(qctr, 1u);
                __syncthreads();
                const int u = __builtin_amdgcn_readfirstlane((int)MISC[0]);
                __syncthreads();
                if (u >= 2048) break;
                attn_body::attn_unit<60>((u & 63) >> 3, u & 7, 31 - (u >> 6), qa_, ka_, va_, (attn_body::bf16*)OA, lf_, (const float*)(ws + WS_CTL) + 128, (char*)lds, wave);
            } }
    } }
    SEAM(2);
    for (int rep = 0; rep < NREP(3); ++rep) if (IN(3)) {
        { pg8::Gemm g{OA, Wao, MP, 1024, 512}; pg8::StaticOrder S; S.init(MP, 1024, G, bx); epi::EpiMerge<0> E{GA, MG}; epi::light_gemm(OA, Wao, 1024, 512, E, wave, bx, G, ldsl);
          pg8::gemm_phase<epi::EpiMerge<0>, pg8::StaticOrder, true, true>(ldsl, g, S, E, wave); }
        { pg8::Gemm g{OBG, Wbo, MP, 1024, 1024}; pg8::StaticOrder S; S.init(MP, 1024, G, bx); epi::EpiMerge<1> E{GB, MG}; epi::light_gemm(OBG, Wbo, 1024, 1024, E, wave, bx, G, ldsl);
          pg8::gemm_phase<epi::EpiMerge<1>, pg8::StaticOrder, true, true>(ldsl, g, S, E, wave); }
    }
    SEAM(3);
    for (int rep = 0; rep < NREP(4); ++rep) if (IN(4)) {
        pg8::Gemm g{MG, Wo, MP, 1024, 1024}; pg8::StaticOrder S; S.init(MP, 1024, G, bx); epi::EpiResX E{x_p, x_s, ZB}; epi::light_gemm(MG, Wo, 1024, 1024, E, wave, bx, G, ldsl);
        pg8::gemm_phase<epi::EpiResX, pg8::StaticOrder, true, true>(ldsl, g, S, E, wave);
    }
    SEAM(4);
    for (int rep = 0; rep < NREP(5); ++rep) if (IN(5)) ln_phase(ZB, XB, nullptr, ln1g, ln1b, gw, NGW, lane);
    SEAM(5);
#pragma unroll 1
    for (int half = 0; half < 2; ++half) {
        for (int rep = 0; rep < NREP(6); ++rep) if (IN(6 + 2 * half)) {
            pg8::Gemm g{XB, Wup + (size_t)half * DFF * 1024, MP, DFF, 1024}; pg8::StaticOrder S; S.init(MP, DFF, G, bx); epi::EpiUp E{UP, out, half}; epi::light_gemm_wide(XB, Wup + (size_t)half * DFF * 1024, DFF, 1024, E, wave, bx, G, ldsl);
            pg8::gemm_phase<epi::EpiUp, pg8::StaticOrder, true, true>(ldsl, g, S, E, wave);
        }
        SEAM(6 + 2 * half);
        for (int rep = 0; rep < NREP(7); ++rep) if (IN(7 + 2 * half)) conv_phase(UP, HB, conv_w, conv_b, cconv, half, gw, NGW, lane);
        SEAM(7 + 2 * half);
    }
    for (int rep = 0; rep < NREP(10); ++rep) if (IN(10)) {
        pg8::Gemm g{HB, Wdn, MP, 1024, DFF}; pg8::StaticOrder S; S.init(MP, 1024, G, bx); epi::EpiResB<0> E{XB, ZB, nullptr}; epi::light_gemm(HB, Wdn, 1024, DFF, E, wave, bx, G, ldsl);
        pg8::gemm_phase<epi::EpiResB<0>, pg8::StaticOrder, true, true>(ldsl, g, S, E, wave);
    }
    SEAM(10);
    for (int rep = 0; rep < NREP(5); ++rep) if (IN(11)) ln_phase(ZB, XB, nullptr, ln2g, ln2b, gw, NGW, lane);
    SEAM(11);
    for (int rep = 0; rep < NREP(12); ++rep) if (IN(12)) {
        { int kpl = 256; asm volatile("" : "+s"(kpl)); pg8::Gemm g{PB, Wpl, MP, 1024, kpl}; pg8::StaticOrder S; S.init(MP, 1024, G, bx); epi::EpiStore E{TMP}; epi::light_gemm(PB, Wpl, 1024, kpl, E, wave, bx, G, ldsl);
          pg8::gemm_phase<epi::EpiStore, pg8::StaticOrder, true, true>(ldsl, g, S, E, wave); }
        { pg8::Gemm g{XB, Wplg, MP, 1024, 1024}; pg8::StaticOrder S; S.init(MP, 1024, G, bx); epi::EpiResB<1> E{XB, ZB, TMP}; epi::light_gemm(XB, Wplg, 1024, 1024, E, wave, bx, G, ldsl);
          pg8::gemm_phase<epi::EpiResB<1>, pg8::StaticOrder, true, true>(ldsl, g, S, E, wave); }
    }
    SEAM(12);
    for (int rep = 0; rep < NREP(5); ++rep) if (IN(13)) ln_phase(ZB, nullptr, Y, ln3g, ln3b, gw, NGW, lane);
#undef IN
#undef SEAM
}
#undef out
#undef lane
#undef tid
#undef ws
#undef Y
#undef GA
#undef A1
#undef S0

extern "C" void kernel_launch(void* const* d_in, const int* in_sizes, int n_in, void* d_out, int out_size, void* d_ws, size_t ws_size, hipStream_t stream) {
    static int grid = 0;
    if (grid == 0) {
        int dev = 0, cus = 0;
        if (hipGetDevice(&dev) != hipSuccess || hipDeviceGetAttribute(&cus, hipDeviceAttributeMultiprocessorCount, dev) != hipSuccess) { grid = -1; return; }
        if (hipFuncSetAttribute((const void*)fwd_kernel, hipFuncAttributeMaxDynamicSharedMemorySize, LDS_BYTES) != hipSuccess) { fprintf(stderr, "kernel_launch: hipFuncSetAttribute failed\n"); grid = -1; return; }
        int per_cu = 0;
        if (hipOccupancyMaxActiveBlocksPerMultiprocessor(&per_cu, (const void*)fwd_kernel, 512, LDS_BYTES) != hipSuccess || per_cu < 1) { fprintf(stderr, "kernel_launch: occupancy query says %d\n", per_cu); per_cu = 1; }
        (void)hipGetLastError();
        grid = cus;
        if (n_in != 29 || ws_size < (size_t)1000 * MiB) fprintf(stderr, "kernel_launch: unexpected n_in %d / ws %zu\n", n_in, ws_size);
    }
    if (grid < 0) return;
    (void)hipMemsetAsync((char*)d_ws + WS_CTL, 0, 65536, stream);
    Args a{};
    for (int i = 0; i < 29; ++i) a.in[i] = (const float*)d_in[i];
    a.out = (float*)d_out; a.ws = (unsigned char*)d_ws;
#if ONE_LAUNCH
    a.ph_lo = 0; a.ph_hi = N_PHASES;
    void* kargs[] = {&a};
    hipError_t e = hipLaunchCooperativeKernel((const void*)fwd_kernel, dim3(grid), dim3(512), kargs, LDS_BYTES, stream);
    if (e != hipSuccess) fprintf(stderr, "cooperative launch failed: %s (grid %d)\n", hipGetErrorString(e), grid);
#else
    for (int p = 0; p < N_PHASES; ++p) { a.ph_lo = p; a.ph_hi = p + 1; hipLaunchKernelGGL(fwd_kernel, dim3(grid), dim3(512), LDS_BYTES, stream, a); }
#endif
}
```

```cpp
#include <hip/hip_runtime.h>
#include <hip/hip_cooperative_groups.h>
#include <hip/hip_bf16.h>
#include <cstdio>
#include <cstdint>
#include <cmath>
#ifndef ONE_LAUNCH
#define ONE_LAUNCH 1
#endif
constexpr int DM_ = 1024, TSEQ = 8192, MP = 65536, MROWS = 65664, MPAD = 65792;
constexpr int DFF = 2816;
constexpr float LN_EPS = 1e-5f;
constexpr float ALPHA = 1.189207115002721f;
constexpr size_t O_Y = 0, O_KP = 67239936, O_VP = 100794368, O_FP = 134348800, O_SP = 134873088, O_CP = 135921664,
                 O_KS = 136011776, O_VS = 136077312, O_FS = 136142848, O_SS = 136143872, O_CS = 137192448;
__device__ __forceinline__ int lane_id_asm() { int l; asm volatile("v_mbcnt_lo_u32_b32 %0, -1, 0\n\tv_mbcnt_hi_u32_b32 %0, -1, %0" : "=v"(l)); return l; }
#define TIDX(wv) ((wv) * 64 + lane_id_asm())
namespace pg8 {
#define PG8_LAS __attribute__((address_space(3)))
typedef unsigned short bf16_t;
typedef short bf16x8 __attribute__((ext_vector_type(8)));
typedef float f32x4 __attribute__((ext_vector_type(4)));
typedef unsigned u32x4 __attribute__((ext_vector_type(4)));
constexpr int BM = 256, BK = 64, HALF = 128, HTB = HALF * BK * 2  , STAGE_BYTES = 8 * HTB, NXCD = 8, WGM = 4;

__host__ __device__ __forceinline__ int lds_byte(int r, int c) { const int st = (r >> 4) * 2 + (c >> 5), rr = r & 15, cc = c & 31, ob = rr * 64 + cc * 2; return st * 1024 + (ob ^ (((ob >> 9) & 1) << 5)); }
__host__ __device__ __forceinline__ void stage_rc(int b, int& R, int& C) { const int st = b / 1024, sb = b % 1024, swz = sb ^ (((sb >> 9) & 1) << 5); R = (st >> 1) * 16 + swz / 64; C = (st & 1) * 32 + (swz % 64) / 2; }
__host__ __device__ __forceinline__ int perm32(int rho) { const int n = rho >> 4, i = rho & 15; return 8 * (i >> 2) + 4 * n + (i & 3); }

struct Unit { int pm, pn; };
struct Gemm { const bf16_t* A; const bf16_t* Bt; int M, N, K; };

struct StaticOrder {
    int nM, nN, nwg, G, c;
    __host__ __device__ void init(int M, int N, int G_, int c_) { nM = M / BM; nN = N / BM; nwg = nM * nN; G = G_; c = c_; }
    __host__ __device__ bool next(int i, Unit& u) const {
        const long L = (long)i * G + c; if (L >= nwg) return false;
        int wgid = (int)L; { const int q = nwg / NXCD, r = nwg % NXCD, xcd = wgid % NXCD, off = wgid / NXCD; wgid = (xcd < r ? xcd * (q + 1) : r * (q + 1) + (xcd - r) * q) + off; }
        const int nig = WGM * nN, gid = wgid / nig, fm = gid * WGM, gsz = (nM - fm) < WGM ? (nM - fm) : WGM;
        u.pm = fm + ((wgid % nig) % gsz); u.pn = (wgid % nig) / gsz; return true;
    }
    __device__ __forceinline__ void a_ready(const Unit&) const {}
    __device__ __forceinline__ void done(const Unit&) const {}
};

__device__ __forceinline__ unsigned cvt_pk_bf16(float lo, float hi) { unsigned r; asm volatile("v_cvt_pk_bf16_f32 %0, %1, %2" : "=v"(r) : "v"(lo), "v"(hi)); return r; }
template <class Epi, class Sched, bool ALIGN_EPI = false, bool SP2 = false>
__device__ __forceinline__ void gemm_phase(PG8_LAS unsigned char* lds, const Gemm g, const Sched& S, const Epi& E, const int wv) {
    const int tid = TIDX(wv), wid = wv, lane = tid & 63, wr = wid >> 2, wc = wid & 3, fr = lane & 15, fq = lane >> 4;
    const int K = g.K, nt = K / BK;
    unsigned voffA[2], voffB[2];
#pragma unroll
    for (int i = 0; i < 2; ++i) { int R, C; stage_rc(tid * 16 + i * 8192, R, C); const int Rb = Epi::PERM ? ((R & ~31) + perm32(R & 31)) : R;
        voffA[i] = (unsigned)(R * K + C) * 2u; voffB[i] = (unsigned)(Rb * K + C) * 2u; }
    const size_t kstep = (size_t)(BK * 2);
    const size_t hstep = (size_t)HALF * K * 2;
    const size_t tstep = 2 * hstep;
    const unsigned ldsw = (unsigned)wid * 1024u;
    const int aoff = lds_byte(wr * 64 + fr, fq * 8), boff = lds_byte(wc * 32 + fr, fq * 8);
#define PG8_SA(b, h) (((b) * 2 + (h)) * HTB)
#define PG8_SB(b, h) ((4 + (b) * 2 + (h)) * HTB)
#define PG8_STAGE(bufoff, gbase, voff) do { _Pragma("unroll") for (int _i = 0; _i < 2; ++_i) \
        __builtin_amdgcn_global_load_lds((const unsigned*)((const char*)(gbase) + (voff)[_i]), (PG8_LAS unsigned*)(lds + (bufoff) + ldsw + _i * 8192), 16, 0, 0); } while (0)
#define PG8_LDA(dst, b, h) do { _Pragma("unroll") for (int m = 0; m < 4; ++m) _Pragma("unroll") for (int k = 0; k < 2; ++k) dst[m][k] = *(const PG8_LAS bf16x8*)(lds + PG8_SA(b, h) + aoff + m * 2048 + k * 1024); } while (0)
#define PG8_LDB(dst, b, h) do { _Pragma("unroll") for (int n = 0; n < 2; ++n) _Pragma("unroll") for (int k = 0; k < 2; ++k) dst[n][k] = *(const PG8_LAS bf16x8*)(lds + PG8_SB(b, h) + boff + n * 2048 + k * 1024); } while (0)
#define PG8_MMA(ai, bj, At, Bt) do { __builtin_amdgcn_s_setprio(1); _Pragma("unroll") for (int m = 0; m < 4; ++m) _Pragma("unroll") for (int n = 0; n < 2; ++n) _Pragma("unroll") for (int k = 0; k < 2; ++k) \
        acc[ai][bj][m][n] = __builtin_amdgcn_mfma_f32_16x16x32_bf16(Bt[n][k], At[m][k], acc[ai][bj][m][n], 0, 0, 0); __builtin_amdgcn_s_setprio(0); } while (0)
#define PG8_WAIT_V(n) asm volatile("s_waitcnt vmcnt(" #n ")" ::: "memory")
#define PG8_WAIT_L(n) asm volatile("s_waitcnt lgkmcnt(" #n ")" ::: "memory")
#define PG8_BAR __builtin_amdgcn_s_barrier()
#define PG8_SCHED __builtin_amdgcn_sched_barrier(0)
    Unit cur, nxt; int ui = 0;
    if (!S.next(0, cur)) return;
    f32x4 acc[2][2][4][2];
#pragma unroll
    for (int a = 0; a < 2; ++a)
#pragma unroll
        for (int b = 0; b < 2; ++b)
#pragma unroll
            for (int m = 0; m < 4; ++m)
#pragma unroll
                for (int n = 0; n < 2; ++n) acc[a][b][m][n] = (f32x4){0.f, 0.f, 0.f, 0.f};
    bf16x8 At[4][2], B0[2][2], B1[2][2];
    const char* cA = (const char*)g.A + (size_t)cur.pm * tstep; const char* cB = (const char*)g.Bt + (size_t)cur.pn * tstep;
    S.a_ready(cur);
    if constexpr (SP2) {
        PG8_STAGE(PG8_SB(0, 0), cB, voffB); PG8_STAGE(PG8_SB(0, 1), cB + hstep, voffB); PG8_STAGE(PG8_SA(0, 0), cA, voffA); PG8_STAGE(PG8_SA(0, 1), cA + hstep, voffA);
        if (wr == 1) PG8_BAR;
        PG8_WAIT_V(2); PG8_BAR;
        PG8_STAGE(PG8_SB(1, 0), cB + kstep, voffB); PG8_STAGE(PG8_SA(1, 0), cA + kstep, voffA); PG8_STAGE(PG8_SB(1, 1), cB + hstep + kstep, voffB);
        PG8_WAIT_V(6); PG8_BAR;
    } else {
        PG8_STAGE(PG8_SB(0, 0), cB, voffB); PG8_STAGE(PG8_SA(0, 0), cA, voffA); PG8_STAGE(PG8_SB(0, 1), cB + hstep, voffB); PG8_STAGE(PG8_SA(0, 1), cA + hstep, voffA);
        if (wr == 1) PG8_BAR;
        PG8_WAIT_V(4); PG8_BAR;
        PG8_STAGE(PG8_SB(1, 0), cB + kstep, voffB); PG8_STAGE(PG8_SA(1, 0), cA + kstep, voffA); PG8_STAGE(PG8_SB(1, 1), cB + hstep + kstep, voffB);
        PG8_WAIT_V(6); PG8_BAR;
    }
    for (;;) {
        const bool has_next = S.next(ui + 1, nxt);
        const char* nA = has_next ? (const char*)g.A + (size_t)nxt.pm * tstep : cA; const char* nB = has_next ? (const char*)g.Bt + (size_t)nxt.pn * tstep : cB;
        for (int t = 0; t < nt; t += 2) {
            const bool last = (t == nt - 2);
            const char* a1 = cA + (size_t)(t + 1) * kstep;
            const char* a2 = last ? nA : cA + (size_t)(t + 2) * kstep; const char* b2 = last ? nB : cB + (size_t)(t + 2) * kstep;
            const char* a3 = a2 + kstep; const char* b3 = b2 + kstep;
            if (last && has_next) S.a_ready(nxt);
            if constexpr (SP2) {
            PG8_LDB(B0, 0, 0); PG8_LDB(B1, 0, 1); PG8_SCHED; PG8_LDA(At, 0, 0); PG8_STAGE(PG8_SA(1, 1), a1 + hstep, voffA);
            PG8_WAIT_V(8); PG8_WAIT_L(0); PG8_BAR; PG8_MMA(0, 0, At, B0); PG8_MMA(0, 1, At, B1); PG8_BAR; PG8_SCHED;
            PG8_LDA(At, 0, 1); PG8_STAGE(PG8_SB(0, 0), b2, voffB); PG8_STAGE(PG8_SB(0, 1), b2 + hstep, voffB); PG8_STAGE(PG8_SA(0, 0), a2, voffA);
            PG8_WAIT_V(8); PG8_WAIT_L(0); PG8_BAR; PG8_MMA(1, 0, At, B0); PG8_MMA(1, 1, At, B1); PG8_BAR; PG8_SCHED;
            PG8_LDB(B0, 1, 0); PG8_LDB(B1, 1, 1); PG8_SCHED; PG8_LDA(At, 1, 0); PG8_STAGE(PG8_SA(0, 1), a2 + hstep, voffA);
            PG8_WAIT_V(8); PG8_WAIT_L(0); PG8_BAR; PG8_MMA(0, 0, At, B0); PG8_MMA(0, 1, At, B1); PG8_BAR; PG8_SCHED;
            PG8_LDA(At, 1, 1); PG8_STAGE(PG8_SB(1, 0), b3, voffB); PG8_STAGE(PG8_SB(1, 1), b3 + hstep, voffB); PG8_STAGE(PG8_SA(1, 0), a3, voffA);
            PG8_WAIT_V(8); PG8_WAIT_L(0); PG8_BAR; PG8_MMA(1, 0, At, B0); PG8_MMA(1, 1, At, B1); PG8_BAR; PG8_SCHED;
            } else {
            PG8_LDB(B0, 0, 0); PG8_SCHED; PG8_LDA(At, 0, 0); PG8_STAGE(PG8_SA(1, 1), a1 + hstep, voffA);
            PG8_WAIT_L(8); PG8_BAR; PG8_WAIT_L(0); PG8_MMA(0, 0, At, B0); PG8_BAR; PG8_SCHED;
            PG8_LDB(B1, 0, 1); PG8_STAGE(PG8_SB(0, 0), b2, voffB);
            PG8_BAR; PG8_WAIT_L(0); PG8_MMA(0, 1, At, B1); PG8_BAR;
            PG8_LDA(At, 0, 1); PG8_STAGE(PG8_SA(0, 0), a2, voffA);
            PG8_BAR; PG8_WAIT_L(0); PG8_MMA(1, 0, At, B0); PG8_BAR; PG8_SCHED;
            PG8_STAGE(PG8_SB(0, 1), b2 + hstep, voffB);
            PG8_WAIT_V(6); PG8_BAR; PG8_MMA(1, 1, At, B1); PG8_BAR;
            PG8_LDB(B0, 1, 0); PG8_SCHED; PG8_LDA(At, 1, 0); PG8_STAGE(PG8_SA(0, 1), a2 + hstep, voffA);
            PG8_WAIT_L(8); PG8_BAR; PG8_WAIT_L(0); PG8_MMA(0, 0, At, B0); PG8_BAR; PG8_SCHED;
            PG8_LDB(B1, 1, 1); PG8_STAGE(PG8_SB(1, 0), b3, voffB);
            PG8_BAR; PG8_WAIT_L(0); PG8_MMA(0, 1, At, B1); PG8_BAR;
            PG8_LDA(At, 1, 1); PG8_STAGE(PG8_SA(1, 0), a3, voffA);
            PG8_BAR; PG8_WAIT_L(0); PG8_MMA(1, 0, At, B0); PG8_BAR; PG8_SCHED;
            PG8_STAGE(PG8_SB(1, 1), b3 + hstep, voffB);
            PG8_WAIT_V(6); PG8_BAR; PG8_MMA(1, 1, At, B1); PG8_BAR;
            }
        }
        if constexpr (ALIGN_EPI) { if (wr == 0) PG8_BAR; }
        if constexpr (!Epi::AFTER_DRAIN) { E(acc, cur, wr, wc, fr, fq); S.done(cur); }
        if (!has_next) break;
#pragma unroll
        for (int a = 0; a < 2; ++a)
#pragma unroll
            for (int b = 0; b < 2; ++b)
#pragma unroll
                for (int m = 0; m < 4; ++m)
#pragma unroll
                    for (int n = 0; n < 2; ++n) acc[a][b][m][n] = (f32x4){0.f, 0.f, 0.f, 0.f};
        cur = nxt; cA = nA; cB = nB; ++ui;
        if constexpr (ALIGN_EPI) { if (wr == 1) PG8_BAR; }
    }
    PG8_WAIT_V(0);
    if constexpr (!ALIGN_EPI) { if (wr == 0) PG8_BAR; }
    PG8_BAR;
    if constexpr (Epi::AFTER_DRAIN) { E.fused(acc, cur, wr, wc, fr, fq, lds, wid, lane); S.done(cur); }
#undef PG8_SA
#undef PG8_SB
#undef PG8_STAGE
#undef PG8_LDA
#undef PG8_LDB
#undef PG8_MMA
#undef PG8_WAIT_V
#undef PG8_WAIT_L
#undef PG8_BAR
#undef PG8_SCHED
}
}
namespace epi {
using namespace pg8;
__device__ __forceinline__ float bflo(unsigned w) { return __uint_as_float(w << 16); }
__device__ __forceinline__ float bfhi(unsigned w) { return __uint_as_float(w & 0xffff0000u); }
__device__ __forceinline__ float sigm(float x) { return __builtin_amdgcn_rcpf(1.0f + __expf(-x)); }
__device__ __forceinline__ u32x4 pack8(f32x4 a, f32x4 b) { u32x4 w; w.x = cvt_pk_bf16(a[0], a[1]); w.y = cvt_pk_bf16(a[2], a[3]); w.z = cvt_pk_bf16(b[0], b[1]); w.w = cvt_pk_bf16(b[2], b[3]); return w; }
__device__ __forceinline__ void unpack8(u32x4 w, f32x4& a, f32x4& b) { a = (f32x4){bflo(w.x), bfhi(w.x), bflo(w.y), bfhi(w.y)}; b = (f32x4){bflo(w.z), bfhi(w.z), bflo(w.w), bfhi(w.w)}; }
#define EPI_LOOP(...) \
    _Pragma("unroll") for (int ai = 0; ai < 2; ++ai) _Pragma("unroll") for (int m = 0; m < 4; ++m) { const int row = u.pm * BM + ai * HALF + wr * 64 + m * 16 + fr; \
        _Pragma("unroll") for (int bj = 0; bj < 2; ++bj) { const int cl = bj * HALF + wc * 32 + 8 * fq; f32x4 v0 = acc[ai][bj][m][0], v1 = acc[ai][bj][m][1]; __VA_ARGS__ } }

struct EpiProj {
    static constexpr bool PERM = true, AFTER_DRAIN = false;
    bf16_t *QA, *KA, *VA, *QB, *KB, *VB, *RB, *GA, *GB; float* A1; float* out; const float* bfg; unsigned* kmax; const float* ggla;
    __device__ __forceinline__ void core(int row, int gc, f32x4 v0, f32x4 v1) const {
        const int pn = gc >> 8, cl = gc & 255;
        if (pn < 26) {
            bf16_t* dst; int ld, c0; float sc = 1.f; long fo_s = -1;
            if (pn < 2) { dst = QA; ld = 512; c0 = pn * 256; sc = 0.125f * 1.4426950408889634f; }
            else if (pn < 4) { dst = KA; ld = 512; c0 = (pn - 2) * 256; fo_s = (long)O_KS; }
            else if (pn < 6) { dst = VA; ld = 512; c0 = (pn - 4) * 256; fo_s = (long)O_VS; }
            else if (pn < 8) { dst = QB; ld = 512; c0 = (pn - 6) * 256; }
            else if (pn < 10) { dst = KB; ld = 512; c0 = (pn - 8) * 256; }
            else if (pn < 14) { dst = VB; ld = 1024; c0 = (pn - 10) * 256; }
            else if (pn < 18) { dst = RB; ld = 1024; c0 = (pn - 14) * 256; }
            else if (pn < 22) { dst = GA; ld = 1024; c0 = (pn - 18) * 256; }
            else { dst = GB; ld = 1024; c0 = (pn - 22) * 256; }
            const int col = c0 + cl;
            if (pn >= 14 && pn < 18) { const f32x4 g0 = *(const f32x4*)(ggla + col), g1 = *(const f32x4*)(ggla + col + 4);
                _Pragma("unroll") for (int i = 0; i < 4; ++i) { v0[i] = v0[i] * sigm(v0[i]) * g0[i]; v1[i] = v1[i] * sigm(v1[i]) * g1[i]; } }
            *(u32x4*)(dst + (size_t)row * ld + col) = pack8(v0 * sc, v1 * sc);
            if (fo_s >= 0) { float* fp = out + fo_s + (size_t)(row - MP) * 512 + col; *(f32x4*)fp = v0; *(f32x4*)(fp + 4) = v1; }
        } else if (cl < 8) { float* fp = out + O_FS + (size_t)(row - MP) * 8; f32x4 o0, o1;
            _Pragma("unroll") for (int i = 0; i < 4; ++i) { float z = v0[i] + bfg[i]; o0[i] = fminf(z, 0.f) - log1pf(expf(-fabsf(z))); z = v1[i] + bfg[4 + i]; o1[i] = fminf(z, 0.f) - log1pf(expf(-fabsf(z))); }
            *(f32x4*)fp = o0; *(f32x4*)(fp + 4) = o1;
        } else if (cl < 24) { float* fp = A1 + (size_t)row * 16 + (cl - 8); *(f32x4*)fp = v0; *(f32x4*)(fp + 4) = v1; }
    }
    __device__ __forceinline__ void operator()(const f32x4 (&acc)[2][2][4][2], const Unit& u, int wr, int wc, int fr, int fq) const {
        const int pn = u.pn;
        if (pn < 26) {
            bf16_t* dst; int ld, c0; float sc = 1.f; long fo_p = -1, fo_s = -1;
            if (pn < 2) { dst = QA; ld = 512; c0 = pn * 256; sc = 0.125f * 1.4426950408889634f; }
            else if (pn < 4) { dst = KA; ld = 512; c0 = (pn - 2) * 256; fo_p = (long)O_KP; fo_s = (long)O_KS; }
            else if (pn < 6) { dst = VA; ld = 512; c0 = (pn - 4) * 256; fo_p = (long)O_VP; fo_s = (long)O_VS; }
            else if (pn < 8) { dst = QB; ld = 512; c0 = (pn - 6) * 256; }
            else if (pn < 10) { dst = KB; ld = 512; c0 = (pn - 8) * 256; }
            else if (pn < 14) { dst = VB; ld = 1024; c0 = (pn - 10) * 256; }
            else if (pn < 18) { dst = RB; ld = 1024; c0 = (pn - 14) * 256; }
            else if (pn < 22) { dst = GA; ld = 1024; c0 = (pn - 18) * 256; }
            else { dst = GB; ld = 1024; c0 = (pn - 22) * 256; }
            const bool trk = (pn == 2 || pn == 3) && u.pm < 256; float km0 = 0.f, km1 = 0.f;
            EPI_LOOP({ const int col = c0 + cl;
                if (trk) { float sq = (v0[0] * v0[0] + v0[1] * v0[1]) + (v0[2] * v0[2] + v0[3] * v0[3]) + (v1[0] * v1[0] + v1[1] * v1[1]) + (v1[2] * v1[2] + v1[3] * v1[3]);
                    sq += __shfl_xor(sq, 16); sq += __shfl_xor(sq, 32);
                    if (bj == 0) km0 = fmaxf(km0, sq); else km1 = fmaxf(km1, sq); }
                if (pn >= 14 && pn < 18) { const f32x4 g0 = *(const f32x4*)(ggla + col), g1 = *(const f32x4*)(ggla + col + 4);
                    _Pragma("unroll") for (int i = 0; i < 4; ++i) { v0[i] = v0[i] * sigm(v0[i]) * g0[i]; v1[i] = v1[i] * sigm(v1[i]) * g1[i]; } }
                __builtin_nontemporal_store(pack8(v0 * sc, v1 * sc), (u32x4*)(dst + (size_t)row * ld + col));
                if (fo_p >= 0 && row < MROWS) { float* fp = row < MP ? out + fo_p + (size_t)row * 512 + col : out + fo_s + (size_t)(row - MP) * 512 + col; __builtin_nontemporal_store(v0, (f32x4*)fp); __builtin_nontemporal_store(v1, (f32x4*)(fp + 4)); } })
            if (trk) {
#pragma unroll
                for (int o_ = 1; o_ < 64; o_ <<= 1) { km0 = fmaxf(km0, __shfl_xor(km0, o_)); km1 = fmaxf(km1, __shfl_xor(km1, o_)); }
                if ((fr | fq) == 0) { const int bb = (u.pm * BM) >> 13, hd = (pn - 2) * 4 + (wc >> 1);
                    atomicMax(kmax + ((bb * 8 + hd) * 2 + (wc & 1)), __float_as_uint(km0)); atomicMax(kmax + ((bb * 8 + hd + 2) * 2 + (wc & 1)), __float_as_uint(km1)); } }
        } else {
            if (wc == 0) {
                EPI_LOOP({ if (bj == 0) {
                    if (fq == 0) { if (row < MROWS) { float* fp = row < MP ? out + O_FP + (size_t)row * 8 : out + O_FS + (size_t)(row - MP) * 8;
                            f32x4 o0, o1;
                            _Pragma("unroll") for (int i = 0; i < 4; ++i) { float z = v0[i] + bfg[i]; o0[i] = fminf(z, 0.f) - log1pf(expf(-fabsf(z))); z = v1[i] + bfg[4 + i]; o1[i] = fminf(z, 0.f) - log1pf(expf(-fabsf(z))); }
                            *(f32x4*)fp = o0; *(f32x4*)(fp + 4) = o1; } }
                    else if (fq < 3) { float* fp = A1 + (size_t)row * 16 + (fq - 1) * 8; *(f32x4*)fp = v0; *(f32x4*)(fp + 4) = v1; } } })
            }
        }
    }
};
template <int SECOND> struct EpiMerge {
    static constexpr bool PERM = true, AFTER_DRAIN = false;
    const bf16_t* G; bf16_t* MG;
    __device__ __forceinline__ void core(int row, int gc, f32x4 v0, f32x4 v1) const {
        const size_t off = (size_t)row * 1024 + gc; f32x4 g0, g1; unpack8(__builtin_nontemporal_load((const u32x4*)(G + off)), g0, g1);
        _Pragma("unroll") for (int i = 0; i < 4; ++i) { v0[i] *= sigm(g0[i]); v1[i] *= sigm(g1[i]); }
        if (SECOND) { f32x4 p0, p1; unpack8(*(const u32x4*)(MG + off), p0, p1); v0 += p0; v1 += p1; }
        *(u32x4*)(MG + off) = pack8(v0, v1);
    }
    __device__ __forceinline__ void operator()(const f32x4 (&acc)[2][2][4][2], const Unit& u, int wr, int wc, int fr, int fq) const {
        EPI_LOOP({ core(row, u.pn * BM + cl, v0, v1); })
    }
};
struct EpiResX {
    static constexpr bool PERM = true, AFTER_DRAIN = false;
    const float* xp; const float* xs; bf16_t* Z;
    __device__ __forceinline__ void core(int row, int gc, f32x4 v0, f32x4 v1) const {
        const size_t off = (size_t)row * 1024 + gc; f32x4 x0 = {0.f, 0.f, 0.f, 0.f}, x1 = {0.f, 0.f, 0.f, 0.f};
        if (row < MROWS) { const float* b = row < MP ? xp + off : xs + (off - (size_t)MP * 1024); x0 = *(const f32x4*)b; x1 = *(const f32x4*)(b + 4); }
        *(u32x4*)(Z + off) = pack8(x0 * ALPHA + v0, x1 * ALPHA + v1);
    }
    __device__ __forceinline__ void operator()(const f32x4 (&acc)[2][2][4][2], const Unit& u, int wr, int wc, int fr, int fq) const {
        EPI_LOOP({ core(row, u.pn * BM + cl, v0, v1); })
    }
};
template <int MUL> struct EpiResB {
    static constexpr bool PERM = true, AFTER_DRAIN = false;
    const bf16_t* bb; bf16_t* Z; const bf16_t* mul;
    __device__ __forceinline__ void core(int row, int gc, f32x4 v0, f32x4 v1) const {
        const size_t off = (size_t)row * 1024 + gc; f32x4 x0, x1; unpack8(*(const u32x4*)(bb + off), x0, x1);
        if (MUL) { f32x4 m0, m1; unpack8(*(const u32x4*)(mul + off), m0, m1);
            _Pragma("unroll") for (int i = 0; i < 4; ++i) { v0[i] = m0[i] * sigm(v0[i]); v1[i] = m1[i] * sigm(v1[i]); } }
        *(u32x4*)(Z + off) = pack8(x0 * ALPHA + v0, x1 * ALPHA + v1);
    }
    __device__ __forceinline__ void operator()(const f32x4 (&acc)[2][2][4][2], const Unit& u, int wr, int wc, int fr, int fq) const {
        EPI_LOOP({ core(row, u.pn * BM + cl, v0, v1); })
    }
};
struct EpiStore {
    static constexpr bool PERM = true, AFTER_DRAIN = false;
    bf16_t* T;
    __device__ __forceinline__ void core(int row, int gc, f32x4 v0, f32x4 v1) const { *(u32x4*)(T + (size_t)row * 1024 + gc) = pack8(v0, v1); }
    __device__ __forceinline__ void operator()(const f32x4 (&acc)[2][2][4][2], const Unit& u, int wr, int wc, int fr, int fq) const {
        EPI_LOOP({ core(row, u.pn * BM + cl, v0, v1); })
    }
};
struct EpiUp {
    static constexpr bool PERM = true, AFTER_DRAIN = false;
    bf16_t* UP; float* out; int half;
    __device__ __forceinline__ void core(int row, int gc, f32x4 v0, f32x4 v1) const {
        *(u32x4*)(UP + (size_t)row * DFF + gc) = pack8(v0, v1);
        const int t = (row - MP) & 15;
        if (t >= 14) { const int jg = half * 11 + (gc >> 8), cl = gc & 255; const int oc = (cl < 128 ? 0 : DFF - 128) + 128 * jg + cl;
            float* fp = out + O_CS + ((size_t)((row - MP) >> 4) * 2 + (t - 14)) * 5632 + oc; *(f32x4*)fp = v0; *(f32x4*)(fp + 4) = v1; }
    }
    __device__ __forceinline__ void operator()(const f32x4 (&acc)[2][2][4][2], const Unit& u, int wr, int wc, int fr, int fq) const {
        const int jg = half * 11 + u.pn;
        EPI_LOOP({ __builtin_nontemporal_store(pack8(v0, v1), (u32x4*)(UP + (size_t)row * DFF + u.pn * BM + cl));
            long fo = -1;
            if (row < MP) { const int t = row & (TSEQ - 1); if (t >= TSEQ - 2) fo = (long)O_CP + ((long)(row >> 13) * 2 + (t - (TSEQ - 2))) * 5632; }
            else if (row < MROWS) { const int t = (row - MP) & 15; if (t >= 14) fo = (long)O_CS + ((long)((row - MP) >> 4) * 2 + (t - 14)) * 5632; }
            if (fo >= 0) { const int oc = (bj == 0 ? 0 : DFF) + 128 * jg + wc * 32 + 8 * fq; float* fp = out + fo + oc; *(f32x4*)fp = v0; *(f32x4*)(fp + 4) = v1; } })
    }
};
template <class Epi> __device__ __forceinline__ void light_gemm(const bf16_t* __restrict__ A, const bf16_t* __restrict__ Bt, int N, int K, const Epi& E, int wv, int bx, int G, PG8_LAS unsigned char* lds) {
    const int lane = lane_id_asm(), l15 = lane & 15, kq = lane >> 4;
    const int ks = K >> 3;
    PG8_LAS f32x4* RED = (PG8_LAS f32x4*)lds;
    for (int un = bx; un < (N >> 2); un += G) {
        const int rb = un & 7, n0 = 32 * (un >> 3);
        const bf16_t* ap = A + (size_t)(MP + 16 * rb + l15) * K + wv * ks + 8 * kq;
        const bf16_t* w0 = Bt + (size_t)(n0 + 8 * (l15 >> 2) + (l15 & 3)) * K + wv * ks + 8 * kq; const bf16_t* w1 = w0 + (size_t)4 * K;
        f32x4 c0 = {0.f, 0.f, 0.f, 0.f}, c1 = {0.f, 0.f, 0.f, 0.f};
#pragma unroll 4
        for (int k = 0; k < ks; k += 32) { const bf16x8 af = *(const bf16x8*)(ap + k), b0 = *(const bf16x8*)(w0 + k), b1 = *(const bf16x8*)(w1 + k);
            c0 = __builtin_amdgcn_mfma_f32_16x16x32_bf16(b0, af, c0, 0, 0, 0); c1 = __builtin_amdgcn_mfma_f32_16x16x32_bf16(b1, af, c1, 0, 0, 0); }
        RED[(wv * 64 + lane) * 2] = c0; RED[(wv * 64 + lane) * 2 + 1] = c1;
        __syncthreads();
        if (wv == 0) {
#pragma unroll
            for (int w = 1; w < 8; ++w) { c0 += RED[(w * 64 + lane) * 2]; c1 += RED[(w * 64 + lane) * 2 + 1]; }
            E.core(MP + 16 * rb + l15, n0 + 8 * kq, c0, c1);
        }
        __syncthreads();
    }
}
template <class Epi> __device__ __forceinline__ void light_gemm_wide(const bf16_t* __restrict__ A, const bf16_t* __restrict__ Bt, int N, int K, const Epi& E, int wv, int bx, int G, PG8_LAS unsigned char* lds) {
    const int lane = lane_id_asm(), l15 = lane & 15, kq = lane >> 4;
    const int ks = K >> 1, rbl = wv & 3, kh = wv >> 2;
    PG8_LAS f32x4* RED = (PG8_LAS f32x4*)lds;
    for (int un = bx; un < (N >> 4); un += G) {
        const int rb = 4 * (un & 1) + rbl, n0 = 32 * (un >> 1);
        const bf16_t* ap = A + (size_t)(MP + 16 * rb + l15) * K + kh * ks + 8 * kq;
        const bf16_t* w0 = Bt + (size_t)(n0 + 8 * (l15 >> 2) + (l15 & 3)) * K + kh * ks + 8 * kq; const bf16_t* w1 = w0 + (size_t)4 * K;
        f32x4 c0 = {0.f, 0.f, 0.f, 0.f}, c1 = {0.f, 0.f, 0.f, 0.f};
#pragma unroll 8
        for (int k = 0; k < ks; k += 32) { const bf16x8 af = *(const bf16x8*)(ap + k), b0 = *(const bf16x8*)(w0 + k), b1 = *(const bf16x8*)(w1 + k);
            c0 = __builtin_amdgcn_mfma_f32_16x16x32_bf16(b0, af, c0, 0, 0, 0); c1 = __builtin_amdgcn_mfma_f32_16x16x32_bf16(b1, af, c1, 0, 0, 0); }
        if (kh == 1) { RED[(rbl * 64 + lane) * 2] = c0; RED[(rbl * 64 + lane) * 2 + 1] = c1; }
        __syncthreads();
        if (kh == 0) { c0 += RED[(rbl * 64 + lane) * 2]; c1 += RED[(rbl * 64 + lane) * 2 + 1]; E.core(MP + 16 * rb + l15, n0 + 8 * kq, c0, c1); }
        __syncthreads();
    }
}
}
#include <hip/hip_bf16.h>
#include <cmath>
namespace attn_body {
using bf16=__hip_bfloat16;
using bf16x8=__attribute__((ext_vector_type(8)))short;
using s16x4=__attribute__((ext_vector_type(4)))short;
using f32x16=__attribute__((ext_vector_type(16)))float;
using u32x4=__attribute__((ext_vector_type(4)))unsigned;
using f32x4a=__attribute__((ext_vector_type(4)))float;
__device__ __forceinline__ __attribute__((address_space(3))) char* shm3f(char*p){return (__attribute__((address_space(3))) char*)p;}
constexpr int BATCH=8,NHEAD=8,SEQ=8192,D=64,DM=NHEAD*D;
constexpr int NW=8,QBLK=32,QB=QBLK*NW,KVBLK=64,NQB=SEQ/QB;
constexpr int ATTN_PITCH=DM, ATTN_UNIT_ROWS=QB;
__device__ __forceinline__ int crow(int r,int hi){return (r&3)+8*(r>>2)+4*hi;}
#define SBAR() __builtin_amdgcn_sched_barrier(0)
__device__ __forceinline__ void cmask(f32x16&p0,f32x16&p1,int jb,int qrel,int hi){
  const float NEG=-INFINITY; int kb=64*jb+4*hi;
  #pragma unroll
  for(int r=0;r<16;++r){int kv=kb+(r&3)+8*(r>>2); if(kv>qrel)p0[r]=NEG; if(kv+32>qrel)p1[r]=NEG;}
}

constexpr int NSLOT=3, SLOTB=8192;
constexpr int LDS_K=0, LDS_V=NSLOT*SLOTB, LDS_WS=2*NSLOT*SLOTB, LDS_OST=LDS_WS+NW*64*4, LDS_CB=LDS_OST+NW*4096, LDS_BYTES=LDS_CB+(SEQ+128)*4;
constexpr float C2=0.125f*1.4426950408889634f;
__device__ __forceinline__ void glds16(const void*gsrc,unsigned lds_dst){unsigned keep;
  asm volatile("s_mov_b32 %0, m0\n\ts_mov_b32 m0, %2\n\ts_nop 0\n\tglobal_load_lds_dwordx4 %1, off\n\ts_mov_b32 m0, %0":"=&s"(keep):"v"(gsrc),"s"(lds_dst):"memory");}
__device__ __forceinline__ float max3f(float a,float b,float c){float r;asm("v_max3_f32 %0, %1, %2, %3":"=v"(r):"v"(a),"v"(b),"v"(c));return r;}
__device__ __forceinline__ float max2f(float a,float b){float r;asm("v_max_f32_e32 %0, %1, %2":"=v"(r):"v"(a),"v"(b));return r;}
__device__ __forceinline__ float fadd_s(float a,float b){float r;asm("v_add_f32_e32 %0, %1, %2":"=v"(r):"v"(a),"v"(b));return r;}
__device__ __forceinline__ float fsub_s(float a,float b){float r;asm("v_sub_f32_e32 %0, %1, %2":"=v"(r):"v"(a),"v"(b));return r;}
typedef float f32x2_t __attribute__((ext_vector_type(2))); typedef __bf16 bf16x2_t __attribute__((ext_vector_type(2)));
__device__ __forceinline__ unsigned cvtpk_s(float lo,float hi){f32x2_t v={lo,hi};bf16x2_t b=__builtin_convertvector(v,bf16x2_t);return __builtin_bit_cast(unsigned,b);}
#define WAIT_BAR(N) asm volatile("s_waitcnt vmcnt(" #N ") lgkmcnt(0)\n\ts_barrier":::"memory")

__device__ __forceinline__ void qkt(f32x16&p0,f32x16&p1,const char*Kslot,const bf16x8*qr,int r32,int hi){
  const char*kb=Kslot+hi*1024+r32*16;
  #pragma unroll
  for(int d0=0;d0<4;++d0){
    const bf16x8 b0=*reinterpret_cast<const bf16x8*>(kb+d0*2048);
    const bf16x8 b1=*reinterpret_cast<const bf16x8*>(kb+d0*2048+512);
    p0=__builtin_amdgcn_mfma_f32_32x32x16_bf16(b0,qr[d0],p0,0,0,0);p1=__builtin_amdgcn_mfma_f32_32x32x16_bf16(b1,qr[d0],p1,0,0,0);}
}
typedef __attribute__((address_space(3))) const char* lds_cptr;
typedef short v4i16_t __attribute__((ext_vector_type(4)));
__device__ __forceinline__ void kload8(bf16x8*kf,lds_cptr kp){
  kf[0]=*(const __attribute__((address_space(3))) bf16x8*)(kp);      kf[1]=*(const __attribute__((address_space(3))) bf16x8*)(kp+512);
  kf[2]=*(const __attribute__((address_space(3))) bf16x8*)(kp+2048); kf[3]=*(const __attribute__((address_space(3))) bf16x8*)(kp+2560);
  kf[4]=*(const __attribute__((address_space(3))) bf16x8*)(kp+4096); kf[5]=*(const __attribute__((address_space(3))) bf16x8*)(kp+4608);
  kf[6]=*(const __attribute__((address_space(3))) bf16x8*)(kp+6144); kf[7]=*(const __attribute__((address_space(3))) bf16x8*)(kp+6656);
}
__device__ __forceinline__ void kload2(bf16x8*kf,lds_cptr kp,int j){ kf[2*j]=*(const __attribute__((address_space(3))) bf16x8*)(kp+j*2048); kf[2*j+1]=*(const __attribute__((address_space(3))) bf16x8*)(kp+j*2048+512); }
__device__ __forceinline__ s16x4 vtr(lds_cptr p){ return __builtin_bit_cast(s16x4,__builtin_amdgcn_ds_read_tr16_b64_v4i16((__attribute__((address_space(3))) v4i16_t*)p)); }
__device__ __forceinline__ float rowmax(const f32x16&p0,const f32x16&p1){
  float a=max3f(p0[0],p0[1],p1[0]),b=max3f(p0[2],p0[3],p1[1]);a=max3f(a,p1[2],p1[3]);
  #pragma unroll
  for(int r=4;r<16;r+=4){a=max3f(a,p0[r],p0[r+1]);b=max3f(b,p0[r+2],p0[r+3]);a=max3f(a,p1[r],p1[r+1]);b=max3f(b,p1[r+2],p1[r+3]);}
  const float m=max2f(a,b);
  auto rr=__builtin_amdgcn_permlane32_swap(__float_as_uint(m),__float_as_uint(m),false,false);
  return max2f(__uint_as_float(rr[0]),__uint_as_float(rr[1]));
}
__device__ __forceinline__ void pv(f32x16*o,int vb,bf16x8 pa0,bf16x8 pa1,bf16x8 pa2,bf16x8 pa3){
  #pragma unroll
  for(int d0=0;d0<2;++d0){s16x4 lo[4],hi[4];
    #pragma unroll
    for(int ks=0;ks<4;++ks){
      asm volatile("ds_read_b64_tr_b16 %0,%1 offset:%c2":"=&v"(lo[ks]):"v"(vb),"i"(d0*4096+ks*1024):"memory");
      asm volatile("ds_read_b64_tr_b16 %0,%1 offset:%c2":"=&v"(hi[ks]):"v"(vb),"i"(d0*4096+ks*1024+512):"memory");}
    asm volatile("s_waitcnt lgkmcnt(0)":::"memory");SBAR();
    #define PK(k) (bf16x8){lo[k][0],lo[k][1],lo[k][2],lo[k][3],hi[k][0],hi[k][1],hi[k][2],hi[k][3]}
    o[d0]=__builtin_amdgcn_mfma_f32_32x32x16_bf16(pa0,PK(0),o[d0],0,0,0);
    o[d0]=__builtin_amdgcn_mfma_f32_32x32x16_bf16(pa1,PK(1),o[d0],0,0,0);
    o[d0]=__builtin_amdgcn_mfma_f32_32x32x16_bf16(pa2,PK(2),o[d0],0,0,0);
    o[d0]=__builtin_amdgcn_mfma_f32_32x32x16_bf16(pa3,PK(3),o[d0],0,0,0);
    #undef PK
  }
}

#ifndef ATTN_STORE16
#define ATTN_STORE16(p,v) (*(u32x4*)(p)=(v))
#endif
__device__ __forceinline__ void cb_scan(int b,int h,const float*__restrict__ logf,float*__restrict__ cbg,char*shm,const int wv){
  const int tid=TIDX(wv),lane=tid&63,wid=wv; typedef __attribute__((address_space(3))) float lds_f32;
  lds_f32* ws_=(lds_f32*)shm3f(shm); const int j0=16*tid; float sv[16]; float run=0.f;
  const float*lp=logf+((long)b*SEQ+j0)*NHEAD+h;
  _Pragma("unroll") for(int i=0;i<16;++i){ run+=lp[(long)i*NHEAD]; sv[i]=run; }
  float incl=run;
  _Pragma("unroll") for(int o_=1;o_<64;o_<<=1){ const float n_=__shfl_up(incl,o_); if(lane>=o_)incl+=n_; }
  if(lane==63)ws_[wid]=incl;
  __syncthreads();
  float wp=0.f; _Pragma("unroll") for(int w_=0;w_<NW;++w_){ const float x_=ws_[w_]; if(w_<wid)wp+=x_; }
  const float off_=wp+incl-run; float*og=cbg+(long)(b*NHEAD+h)*SEQ+j0;
  _Pragma("unroll") for(int i=0;i<16;++i) og[i]=-(off_+sv[i])*1.4426950408889634f;
  __syncthreads();
}
template<int THRL> __device__ __forceinline__ void attn_unit(int b,int h,int qb,const bf16*Q,const bf16*__restrict__ K,const bf16*__restrict__ V,bf16*O,const float*__restrict__ logf,const float*__restrict__ kmaxp,char*shm,const int wv){
  const int tid=TIDX(wv),lane=tid&63,r32=lane&31,hi=lane>>5; const int wid=wv;
  const long rowbase=(long)b*SEQ; const int q0=qb*QB;
  const bf16*Qw=Q+(rowbase+q0+wid*QBLK)*DM+h*D;
  typedef __attribute__((address_space(3))) float lds_f32; typedef __attribute__((address_space(3))) const float* lds_cf32p;
  { lds_f32* cbw=(lds_f32*)(shm3f(shm)+LDS_CB); const float* cg_=logf+(long)(b*NHEAD+h)*SEQ; const int NK=q0+QB;
    for(int j=4*tid;j<NK;j+=2048) *(__attribute__((address_space(3))) f32x4a*)(cbw+j)=*(const f32x4a*)(cg_+j); }
  bf16x8 qr[4];
  #pragma unroll
  for(int d0=0;d0<4;++d0)qr[d0]=*reinterpret_cast<const bf16x8*>(&Qw[(long)r32*DM+d0*16+hi*8]);
  int T0=0;
  { float q1=0.f;
    _Pragma("unroll") for(int d0=0;d0<4;++d0) _Pragma("unroll") for(int j=0;j<8;++j){ const float x_=__uint_as_float(((unsigned)(unsigned short)qr[d0][j])<<16); q1+=x_*x_; }
    q1+=__shfl_xor(q1,32);
    _Pragma("unroll") for(int o_=1;o_<32;o_<<=1) q1=fmaxf(q1,__shfl_xor(q1,o_));
    lds_f32* cbw=(lds_f32*)(shm3f(shm)+LDS_CB);
    if(lane==0)cbw[SEQ+80+wid]=q1;
    __syncthreads();
    float qm=0.f; _Pragma("unroll") for(int w_=0;w_<NW;++w_) qm=fmaxf(qm,cbw[SEQ+80+w_]);
    const float B2=2.04f*sqrtf(qm*(kmaxp[(b*NHEAD+h)*2]+kmaxp[(b*NHEAD+h)*2+1]));
    const int NT0=(q0+QB)/KVBLK;
    const bool skip=(tid<NT0-4)&&(B2+cbw[64*tid+63]-cbw[q0]<-160.f);
    const int cnt=__syncthreads_count(skip?1:0);
    T0=cnt&~1; if(T0>NT0-4)T0=NT0-4; if(T0<0)T0=0; T0=__builtin_amdgcn_readfirstlane(T0); }
  const bf16*Kh=K+(rowbase+(long)T0*KVBLK)*DM+h*D,*Vh=V+(rowbase+(long)T0*KVBLK)*DM+h*D;
  const unsigned lds0=(unsigned)(uintptr_t)shm;
  float*wsf=(float*)(shm+LDS_WS)+wid*64;
  const bf16*ksrc=Kh+(long)lane*DM+wid*8;
  const bf16*vsrc=Vh+(long)(16*(wid&3)+(lane>>2))*DM+(wid>>2)*32+(lane&3)*8;
  const unsigned kdst=lds0+LDS_K+wid*1024, vdst=lds0+LDS_V+wid*1024;
  #define DMA_K(t,slot) glds16(ksrc+(long)(t)*KVBLK*DM,(unsigned)__builtin_amdgcn_readfirstlane(kdst+(slot)))
  #define DMA_V(t,slot) glds16(vsrc+(long)(t)*KVBLK*DM,(unsigned)__builtin_amdgcn_readfirstlane(vdst+(slot)))
  const int vb0=(int)(lds0+LDS_V)+((lane>>4)&1)*32+(lane&3)*8+(4*hi+((lane&15)>>2))*64;
  const char*Kbase=shm+LDS_K; bf16x8 kf[8];
  const lds_cptr shm3=(lds_cptr)shm; const lds_cptr kp0=shm3+LDS_K+hi*1024+r32*16; const lds_cptr vp0=shm3+LDS_V+((lane>>4)&1)*32+(lane&3)*8+(4*hi+((lane&15)>>2))*64;
  const int NT=(q0+QB)/KVBLK-T0;
  const lds_cf32p cbL=(lds_cf32p)(shm3f(shm)+LDS_CB)+4*hi+T0*KVBLK;
  #define LOADB(X0,X1,tt) do{ const lds_cf32p cp_=cbL+(tt)*64; \
    _Pragma("unroll") for(int g_=0;g_<4;++g_){ const f32x4a a_=*(const __attribute__((address_space(3))) f32x4a*)(cp_+8*g_); const f32x4a b_=*(const __attribute__((address_space(3))) f32x4a*)(cp_+32+8*g_); \
      X0[4*g_]=a_[0]-mhat; X0[4*g_+1]=a_[1]-mhat; X0[4*g_+2]=a_[2]-mhat; X0[4*g_+3]=a_[3]-mhat; \
      X1[4*g_]=b_[0]-mhat; X1[4*g_+1]=b_[1]-mhat; X1[4*g_+2]=b_[2]-mhat; X1[4*g_+3]=b_[3]-mhat; } }while(0)
  DMA_K(0,0);DMA_V(0,0);DMA_K(1,SLOTB);
  float mhat=0.f,l_reg=0.f;f32x16 o[2];o[0]=f32x16{};o[1]=f32x16{};
  const int qrel=wid*QBLK+r32;
  f32x16 pA0,pA1,pB0,pB1; LOADB(pA0,pA1,0);
  #define CMASK(P0,P1,t) do{int jb_=(t)-(NT-4); if(jb_>=0)cmask(P0,P1,jb_,qrel,hi);}while(0)
  bool resc=false;
  #define START(P0,P1) do{ const float rm=rowmax(P0,P1); resc=false; \
    { const float dl=rm; mhat=fadd_s(mhat,dl); \
      _Pragma("unroll") for(int r=0;r<16;++r){P0[r]=fsub_s(P0[r],dl);P1[r]=fsub_s(P1[r],dl);} } \
    _Pragma("unroll") for(int r=0;r<16;++r)P0[r]=__builtin_amdgcn_exp2f(P0[r]); }while(0)
  #define RESC() do{ if(resc){ asm volatile("s_waitcnt lgkmcnt(0)":::"memory"); \
      _Pragma("unroll") for(int d_=0;d_<2;++d_) _Pragma("unroll") for(int r=0;r<16;++r)o[d_][r]*=wsf[crow(r,hi)]; } }while(0)
  int sl_prev=0,sl_cur=0,sl_next=SLOTB;
  #define ROT() do{sl_prev=sl_cur;sl_cur=sl_next;sl_next=(sl_next==(NSLOT-1)*SLOTB)?0:sl_next+SLOTB;}while(0)
  DMA_K(2,2*SLOTB);
  WAIT_BAR(3);
  qkt(pA0,pA1,Kbase,qr,r32,hi);asm volatile("s_nop 15\n\ts_nop 7":"+v"(pA0),"+v"(pA1));CMASK(pA0,pA1,0);
  START(pA0,pA1);
  LOADB(pB0,pB1,1);
  _Pragma("unroll") for(int r=0;r<16;++r)pA1[r]=__builtin_amdgcn_exp2f(pA1[r]);
  WAIT_BAR(0);
  DMA_K(3,0);DMA_V(1,SLOTB);
  ROT();
  kload8(kf,kp0+sl_cur);
  WAIT_BAR(2);
  s16x4 vlo[8],vhi[8]; u32x4 pw0,pw1,pw2,pw3;
  #define PKW(P,B) cvtpk_s(P[B],P[B+1])
  #define PAF(k) __builtin_bit_cast(bf16x8,pw##k)
  #define VFR(i) (bf16x8){vlo[i][0],vlo[i][1],vlo[i][2],vlo[i][3],vhi[i][0],vhi[i][1],vhi[i][2],vhi[i][3]}
  #define PIN(x) asm volatile("":"+v"(x))
  #define MX3(a,b,c) __builtin_fmaxf(__builtin_fmaxf((a),(b)),(c))
  #define GAPA(MF,A0,A1,A2,A3,W0,W1,PW) do{ MF; sacc+=A0; sacc+=A1; sacc+=A2; sacc+=A3; PIN(sacc); W0; W1; PIN(PW); SBAR(); }while(0)
  #define EX(v) __builtin_amdgcn_exp2f(v)
  #define GAPB(MF,X,B) do{ MF; X[B]=EX(X[B]); X[B+1]=EX(X[B+1]); X[B+2]=EX(X[B+2]); X[B+3]=EX(X[B+3]); PIN(X); SBAR(); }while(0)
  #define VRD(i) do{ vlo[i]=vtr(vp_+(((i)>>2)*4096+((i)&3)*1024)); vhi[i]=vtr(vp_+(((i)>>2)*4096+((i)&3)*1024+512)); }while(0)
  #define KRD(G,j) do{ if(G){ kload2(kf,kp0+sl_next,j); SBAR(); } }while(0)
  #define STEP(C0,C1,P0,P1,t,GK,GV,GL) do{ SBAR(); \
    const lds_cptr vp_=vp0+sl_prev; \
    VRD(0); SBAR(); float sacc=(P0[0]+P0[1]); \
    GAPA(C0=__builtin_amdgcn_mfma_f32_32x32x16_bf16(kf[0],qr[0],C0,0,0,0), P0[2],P0[3],P0[4],P0[5],     pw0[0]=PKW(P0,0), pw0[1]=PKW(P0,2), pw0); \
    VRD(4); SBAR(); GAPA(C1=__builtin_amdgcn_mfma_f32_32x32x16_bf16(kf[1],qr[0],C1,0,0,0), P0[6],P0[7],P0[8],P0[9],     pw0[2]=PKW(P0,4), pw0[3]=PKW(P0,6), pw0); \
    VRD(1); SBAR(); GAPA(C0=__builtin_amdgcn_mfma_f32_32x32x16_bf16(kf[2],qr[1],C0,0,0,0),   P0[10],P0[11],P0[12],P0[13], pw1[0]=PKW(P0,8), pw1[1]=PKW(P0,10), pw1); \
    VRD(5); SBAR(); GAPA(C1=__builtin_amdgcn_mfma_f32_32x32x16_bf16(kf[3],qr[1],C1,0,0,0),   P0[14],P0[15],P1[0],P1[1],   pw1[2]=PKW(P0,12),pw1[3]=PKW(P0,14), pw1); \
    VRD(2); SBAR(); GAPA(C0=__builtin_amdgcn_mfma_f32_32x32x16_bf16(kf[4],qr[2],C0,0,0,0),   P1[2],P1[3],P1[4],P1[5],     pw2[0]=PKW(P1,0), pw2[1]=PKW(P1,2), pw2); \
    VRD(6); SBAR(); GAPA(C1=__builtin_amdgcn_mfma_f32_32x32x16_bf16(kf[5],qr[2],C1,0,0,0),   P1[6],P1[7],P1[8],P1[9],     pw2[2]=PKW(P1,4), pw2[3]=PKW(P1,6), pw2); \
    VRD(3); SBAR(); GAPA(C0=__builtin_amdgcn_mfma_f32_32x32x16_bf16(kf[6],qr[3],C0,0,0,0),   P1[10],P1[11],P1[12],P1[13], pw3[0]=PKW(P1,8), pw3[1]=PKW(P1,10), pw3); \
    VRD(7); SBAR(); GAPA(C1=__builtin_amdgcn_mfma_f32_32x32x16_bf16(kf[7],qr[3],C1,0,0,0),   P1[14],P1[15],0.f,0.f,       pw3[2]=PKW(P1,12),pw3[3]=PKW(P1,14), pw3); \
    l_reg+=sacc; \
    if(GK){DMA_K((t)+3,sl_cur);} if(GV){DMA_V((t)+1,sl_next);} \
    CMASK(C0,C1,t); \
    { float a=MX3(C0[0],C0[1],C1[0]),b=MX3(C0[2],C0[3],C1[1]); a=MX3(a,C1[2],C1[3]); \
      _Pragma("unroll") for(int r=4;r<16;r+=4){a=MX3(a,C0[r],C0[r+1]);b=MX3(b,C0[r+2],C0[r+3]);a=MX3(a,C1[r],C1[r+1]);b=MX3(b,C1[r+2],C1[r+3]);} \
      float rm=__builtin_fmaxf(a,b); { auto rr=__builtin_amdgcn_permlane32_swap(__float_as_uint(rm),__float_as_uint(rm),false,false); rm=__builtin_fmaxf(__uint_as_float(rr[0]),__uint_as_float(rr[1])); } \
      resc=false; \
      if(__builtin_expect(__any(rm>(float)THRL),0)){ const float dl=__builtin_fmaxf(rm,0.f); mhat+=dl; \
        _Pragma("unroll") for(int r=0;r<16;++r){C0[r]-=dl;C1[r]-=dl;} \
        const float f=__builtin_amdgcn_exp2f(-dl); l_reg*=f; if(hi==0)wsf[r32]=f; resc=true; } } \
    SBAR(); \
    GAPB(o[0]=__builtin_amdgcn_mfma_f32_32x32x16_bf16(PAF(0),VFR(0),o[0],0,0,0), C0,0); \
    GAPB(o[1]=__builtin_amdgcn_mfma_f32_32x32x16_bf16(PAF(0),VFR(4),o[1],0,0,0), C0,4); \
    KRD(GL,0); GAPB(o[0]=__builtin_amdgcn_mfma_f32_32x32x16_bf16(PAF(1),VFR(1),o[0],0,0,0), C0,8); \
    KRD(GL,1); GAPB(o[1]=__builtin_amdgcn_mfma_f32_32x32x16_bf16(PAF(1),VFR(5),o[1],0,0,0), C0,12); \
    KRD(GL,2); GAPB(o[0]=__builtin_amdgcn_mfma_f32_32x32x16_bf16(PAF(2),VFR(2),o[0],0,0,0), C1,0); \
    KRD(GL,3); GAPB(o[1]=__builtin_amdgcn_mfma_f32_32x32x16_bf16(PAF(2),VFR(6),o[1],0,0,0), C1,4); \
    GAPB(o[0]=__builtin_amdgcn_mfma_f32_32x32x16_bf16(PAF(3),VFR(3),o[0],0,0,0), C1,8); \
    GAPB(o[1]=__builtin_amdgcn_mfma_f32_32x32x16_bf16(PAF(3),VFR(7),o[1],0,0,0), C1,12); \
    LOADB(P0,P1,(t)+1); \
    }while(0)
  int t=1;
  #undef CMASK
  #define CMASK(P0,P1,t) do{}while(0)
  for(;t+5<NT;t+=2){
    STEP(pB0,pB1,pA0,pA1,t,true,true,true);     WAIT_BAR(2); RESC(); ROT();
    STEP(pA0,pA1,pB0,pB1,t+1,true,true,true);   WAIT_BAR(2); RESC(); ROT();
  }
  #undef CMASK
  #define CMASK(P0,P1,t) do{int jb_=(t)-(NT-4); if(jb_>=0)cmask(P0,P1,jb_,qrel,hi);}while(0)
  #define ENDW(tt) do{ if((tt)+3<NT){WAIT_BAR(2);} else if((tt)+2<NT){WAIT_BAR(1);} else {WAIT_BAR(0);} }while(0)
  for(;t+1<NT;t+=2){
    STEP(pB0,pB1,pA0,pA1,t,(t+3<NT),(t+1<NT),(t+1<NT));       ENDW(t);   RESC(); ROT();
    STEP(pA0,pA1,pB0,pB1,t+1,(t+4<NT),(t+2<NT),(t+2<NT));     ENDW(t+1); RESC(); ROT();
  }
  STEP(pB0,pB1,pA0,pA1,NT-1,false,false,false); RESC();
  { float sacc=pB0[0]+pB0[1]; _Pragma("unroll") for(int r=2;r<16;++r)sacc+=pB0[r]; _Pragma("unroll") for(int r=0;r<16;++r)sacc+=pB1[r]; l_reg+=sacc;
    pw0=(u32x4){PKW(pB0,0),PKW(pB0,2),PKW(pB0,4),PKW(pB0,6)};pw1=(u32x4){PKW(pB0,8),PKW(pB0,10),PKW(pB0,12),PKW(pB0,14)};pw2=(u32x4){PKW(pB1,0),PKW(pB1,2),PKW(pB1,4),PKW(pB1,6)};pw3=(u32x4){PKW(pB1,8),PKW(pB1,10),PKW(pB1,12),PKW(pB1,14)};
    SBAR(); pv(o,vb0+sl_cur,PAF(0),PAF(1),PAF(2),PAF(3)); }
  #undef PKW
  #undef PAF
  #undef VFR
  #undef PIN
  #undef MX3
  #undef GAPA
  #undef GAPB
  #undef EX
  #undef VRD
  #undef KRD
  #undef STEP
  #undef ENDW
  {auto rr=__builtin_amdgcn_permlane32_swap(__float_as_uint(l_reg),__float_as_uint(l_reg),false,false);l_reg=__uint_as_float(rr[0])+__uint_as_float(rr[1]);}
  if(hi==0)wsf[32+r32]=l_reg;asm volatile("s_waitcnt lgkmcnt(0)":::"memory");
  float rli[16];
  #pragma unroll
  for(int r=0;r<16;++r)rli[r]=__builtin_amdgcn_rcpf(wsf[32+crow(r,hi)]);
  bf16*Ow=O+(rowbase+q0+wid*QBLK)*DM+h*D;
  { bf16*stg=(bf16*)(shm+LDS_OST)+wid*2048;
    #pragma unroll
    for(int r=0;r<16;++r){const int orow=crow(r,hi);
      #pragma unroll
      for(int d0=0;d0<2;++d0)stg[orow*64+d0*32+r32]=__float2bfloat16(o[d0][r]*rli[r]);}
    asm volatile("s_waitcnt lgkmcnt(0)":::"memory");
    #pragma unroll
    for(int i=0;i<4;++i){const int row=i*8+(lane>>3),ch=lane&7; const u32x4 v=*(const u32x4*)(stg+row*64+ch*8); ATTN_STORE16(Ow+(long)row*DM+ch*8,v);} }
  asm volatile("s_waitcnt lgkmcnt(0)\n\ts_barrier":::"memory");
  #undef DMA_K
  #undef DMA_V
  #undef CMASK
  #undef START
  #undef RESC
  #undef ROT
  #undef LOADB
}
constexpr int ATTN_LDS_BYTES=LDS_BYTES;
#undef SBAR
#undef WAIT_BAR
}
namespace gla {
typedef unsigned short bf16_t;
typedef short bf16x8 __attribute__((ext_vector_type(8)));
typedef short s16x4 __attribute__((ext_vector_type(4)));
typedef float f32x4 __attribute__((ext_vector_type(4)));
typedef float f32x2 __attribute__((ext_vector_type(2)));
typedef float f32x16 __attribute__((ext_vector_type(16)));
typedef unsigned u32x4 __attribute__((ext_vector_type(4)));
typedef unsigned u32x2 __attribute__((ext_vector_type(2)));
#define GLDS __attribute__((address_space(3)))
typedef GLDS unsigned char* ldsp;
constexpr int QT_OFF = 0, QT_RS = 272, KT_OFF = 17408, KH_OFF = 34816, KH_RS = 144, V_OFF = 53248, V_RS = 576, AM_OFF = 90112, AM_RS = 144,
              SEG_OFF = 99328, EBL_OFF = 103424, SSQ_OFF = 103936, W2_OFF = 105984, GV_OFF = 114176, GLA_LDS_BYTES = 115200;
constexpr float SCQ = 0.08838834764831845f;
__device__ __forceinline__ int crow(int r, int hi) { return (r & 3) + 8 * (r >> 2) + 4 * hi; }
__device__ __forceinline__ float bflo(unsigned w) { return __uint_as_float(w << 16); }
__device__ __forceinline__ float bfhi(unsigned w) { return __uint_as_float(w & 0xffff0000u); }
__device__ __forceinline__ unsigned pk(float lo, float hi) { typedef float f2 __attribute__((ext_vector_type(2))); typedef __bf16 b2 __attribute__((ext_vector_type(2))); f2 v = {lo, hi}; b2 b = __builtin_convertvector(v, b2); return __builtin_bit_cast(unsigned, b); }
__device__ __forceinline__ float logsig(float z) { return fminf(z, 0.f) - __logf(1.0f + __expf(-fabsf(z))); }
__device__ __forceinline__ float silu(float x) { return x * __builtin_amdgcn_rcpf(1.0f + __expf(-x)); }
#define GBAR() asm volatile("s_waitcnt lgkmcnt(0)\n\ts_barrier" ::: "memory")
__device__ __forceinline__ s16x4 trrd(ldsp p) { typedef short v4s __attribute__((ext_vector_type(4))); return __builtin_bit_cast(s16x4, __builtin_amdgcn_ds_read_tr16_b64_v4i16((GLDS v4s*)p)); }

template <int MODE> __device__ __forceinline__ void chain(int b, int h, int seg, float* __restrict__ SLOC, float* __restrict__ DTOT, const bf16_t* __restrict__ QB, const bf16_t* __restrict__ KB, const bf16_t* __restrict__ VB, bf16_t* __restrict__ OB, const bf16_t* __restrict__ RB, const float* __restrict__ A1,
                                      const float* __restrict__ w_a2, const float* __restrict__ b_a2, const float* __restrict__ g_gla, float* __restrict__ S_out, char* shm, const int wv) {
    const int tid = TIDX(wv), lane = tid & 63, wid = wv, hi = lane >> 5, r32 = lane & 31;
    const ldsp L = (ldsp)shm;
    GLDS float* W2 = (GLDS float*)(L + W2_OFF); GLDS float* SEG = (GLDS float*)(L + SEG_OFF); GLDS float* EBL = (GLDS float*)(L + EBL_OFF); GLDS float* SSQ = (GLDS float*)(L + SSQ_OFF);
    for (int i = tid; i < 2048; i += 512) W2[i] = w_a2[(i >> 7) * 512 + h * 128 + (i & 127)];
    const int c0 = 2 * lane;
    const float ba0 = b_a2[h * 128 + c0], ba1 = b_a2[h * 128 + c0 + 1];
    GLDS float* GVL = (GLDS float*)(L + GV_OFF);
    if (tid < 256) GVL[tid] = g_gla[h * 256 + tid];
    f32x16 S[4];
#pragma unroll
    for (int i = 0; i < 4; ++i) S[i] = f32x16{};
    const long row00 = (long)b * TSEQ + (long)seg * 1024;
    float dt0 = 0.f, dt1 = 0.f;
    if (MODE == 1) {
        for (int g = 0; g < seg; ++g) { const float* sl = SLOC + ((size_t)((b * 4 + h) * 8 + g) * 128) * 256; const float* dd = DTOT + ((b * 4 + h) * 8 + g) * 128;
#pragma unroll
            for (int cb = 0; cb < 4; ++cb)
#pragma unroll
                for (int r = 0; r < 16; ++r) { const int c = 32 * cb + crow(r, hi); S[cb][r] = __expf(dd[c]) * S[cb][r] + sl[(size_t)c * 256 + 32 * wid + r32]; } }
    }
    unsigned q2[8], k2[8]; float a1r0, a1r1; u32x4 vr[4];
    const unsigned lo4 = (unsigned)lane * 4u, lov = (unsigned)(lane >> 5) * 2048u + (unsigned)(lane & 31) * 16u, lor = (unsigned)r32 * 2048u + (unsigned)hi * 8u;
#define GLA_LOAD(R0) do { const long r0_ = (R0); \
        const char* qu_ = (const char*)(QB + (r0_ + 8 * wid) * 512 + h * 128); const char* ku_ = (const char*)(KB + (r0_ + 8 * wid) * 512 + h * 128); \
        _Pragma("unroll") for (int i = 0; i < 8; ++i) { q2[i] = *(const unsigned*)(qu_ + i * 1024 + lo4); k2[i] = *(const unsigned*)(ku_ + i * 1024 + lo4); } \
        const char* au_ = (const char*)(A1 + (r0_ + 8 * wid) * 16); a1r0 = *(const float*)(au_ + lo4); a1r1 = *(const float*)(au_ + 256 + lo4); \
        const char* vu_ = (const char*)(VB + (r0_ + 2 * wid) * 1024 + h * 256); \
        _Pragma("unroll") for (int j = 0; j < 4; ++j) vr[j] = *(const u32x4*)(vu_ + j * 32768 + lov); } while (0)
    GLA_LOAD(row00);
    GBAR();
    const ldsp vtr0 = L + V_OFF + (8 * hi + ((lane & 15) >> 2)) * V_RS + (32 * wid + 16 * ((lane >> 4) & 1) + 4 * (lane & 3)) * 2;
    for (int n = 0; n < 16; ++n) {
        const long row0 = row00 + 64 * n;
        float bl0[8], bl1[8];
        {
            float z0[8], z1[8];
#pragma unroll
            for (int i = 0; i < 8; ++i) { z0[i] = ba0; z1[i] = ba1; }
#pragma unroll
            for (int r = 0; r < 16; ++r) { const f32x2 w = *(const GLDS f32x2*)(W2 + r * 128 + c0);
#pragma unroll
                for (int i = 0; i < 8; ++i) { const int e = i * 16 + r; const float a = __uint_as_float(__builtin_amdgcn_readlane(__float_as_uint(e < 64 ? a1r0 : a1r1), e & 63)); z0[i] += a * w.x; z1[i] += a * w.y; } }
            float run0 = 0.f, run1 = 0.f;
#pragma unroll
            for (int i = 0; i < 8; ++i) { run0 += logsig(z0[i]) * 0.0625f; run1 += logsig(z1[i]) * 0.0625f; bl0[i] = run0; bl1[i] = run1; }
            *(GLDS f32x2*)(SEG + wid * 128 + c0) = (f32x2){run0, run1};
        }
#pragma unroll
        for (int j = 0; j < 4; ++j) { const int idx = j * 512 + tid; *(GLDS u32x4*)(L + V_OFF + (idx >> 5) * V_RS + (idx & 31) * 16) = vr[j]; }
        GBAR();
        {
            float pre0 = 0.f, pre1 = 0.f, tot0 = 0.f, tot1 = 0.f;
#pragma unroll
            for (int w = 0; w < 8; ++w) { const f32x2 sg = *(const GLDS f32x2*)(SEG + w * 128 + c0); tot0 += sg.x; tot1 += sg.y; if (w < wid) { pre0 += sg.x; pre1 += sg.y; } }
            unsigned kh0[4], kh1[4];
#pragma unroll
            for (int i = 0; i < 8; i += 2) {
                float kx0[2], kx1[2];
#pragma unroll
                for (int d = 0; d < 2; ++d) { const int ii = i + d; const float b0 = pre0 + bl0[ii], b1 = pre1 + bl1[ii];
                    const float qa = bflo(q2[ii]), qb = bfhi(q2[ii]), ka = bflo(k2[ii]), kb = bfhi(k2[ii]);
                    if (MODE == 1) { *(GLDS unsigned*)(L + QT_OFF + (8 * wid + ii) * QT_RS + c0 * 2) = pk(qa * SCQ * __expf(b0), qb * SCQ * __expf(b1));
                    *(GLDS unsigned*)(L + KT_OFF + (8 * wid + ii) * QT_RS + c0 * 2) = pk(ka * __expf(-b0), kb * __expf(-b1)); }
                    kx0[d] = ka * __expf(tot0 - b0); kx1[d] = kb * __expf(tot1 - b1); }
                kh0[i >> 1] = pk(kx0[0], kx0[1]); kh1[i >> 1] = pk(kx1[0], kx1[1]);
            }
            *(GLDS u32x4*)(L + KH_OFF + c0 * KH_RS + wid * 16) = (u32x4){kh0[0], kh0[1], kh0[2], kh0[3]};
            *(GLDS u32x4*)(L + KH_OFF + (c0 + 1) * KH_RS + wid * 16) = (u32x4){kh1[0], kh1[1], kh1[2], kh1[3]};
            if (wid == 0) *(GLDS f32x2*)(EBL + c0) = (f32x2){__expf(tot0), __expf(tot1)};
            dt0 += tot0; dt1 += tot1;
        }
        GBAR();
        if (n + 1 < 16) GLA_LOAD(row0 + 64);
        if (MODE == 1) {
            const int l15 = lane & 15, kq = lane >> 4, tb16 = wid >> 1, sbA = 2 * (wid & 1);
            f32x4 a0 = {0.f, 0.f, 0.f, 0.f}, a1 = {0.f, 0.f, 0.f, 0.f};
#pragma unroll
            for (int kk = 0; kk < 4; ++kk) {
                const bf16x8 qf = *(const GLDS bf16x8*)(L + QT_OFF + (16 * tb16 + l15) * QT_RS + (32 * kk + 8 * kq) * 2);
                const bf16x8 kf0 = *(const GLDS bf16x8*)(L + KT_OFF + (16 * sbA + l15) * QT_RS + (32 * kk + 8 * kq) * 2);
                const bf16x8 kf1 = *(const GLDS bf16x8*)(L + KT_OFF + (16 * sbA + 16 + l15) * QT_RS + (32 * kk + 8 * kq) * 2);
                a0 = __builtin_amdgcn_mfma_f32_16x16x32_bf16(kf0, qf, a0, 0, 0, 0);
                a1 = __builtin_amdgcn_mfma_f32_16x16x32_bf16(kf1, qf, a1, 0, 0, 0);
            }
            const int t = 16 * tb16 + l15, s0 = 16 * sbA + 4 * kq;
#pragma unroll
            for (int i = 0; i < 4; ++i) { if (s0 + i > t) a0[i] = 0.f; if (s0 + 16 + i > t) a1[i] = 0.f; }
            *(GLDS u32x2*)(L + AM_OFF + t * AM_RS + s0 * 2) = (u32x2){pk(a0[0], a0[1]), pk(a0[2], a0[3])};
            *(GLDS u32x2*)(L + AM_OFF + t * AM_RS + (s0 + 16) * 2) = (u32x2){pk(a1[0], a1[1]), pk(a1[2], a1[3])};
        }
        GBAR();
        bf16x8 vf[4];
#pragma unroll
        for (int ks = 0; ks < 4; ++ks) { const s16x4 lo = trrd(vtr0 + ks * 16 * V_RS), hh = trrd(vtr0 + ks * 16 * V_RS + 4 * V_RS); vf[ks] = (bf16x8){lo[0], lo[1], lo[2], lo[3], hh[0], hh[1], hh[2], hh[3]}; }
        f32x16 o[2]; o[0] = f32x16{}; o[1] = f32x16{};
        if (MODE == 1) {
#pragma unroll
        for (int tb = 0; tb < 2; ++tb)
#pragma unroll
            for (int ks = 0; ks < 4; ++ks) { const bf16x8 af = *(const GLDS bf16x8*)(L + AM_OFF + (32 * tb + r32) * AM_RS + (16 * ks + 8 * hi) * 2);
                o[tb] = __builtin_amdgcn_mfma_f32_32x32x16_bf16(vf[ks], af, o[tb], 0, 0, 0); }
        __builtin_amdgcn_sched_barrier(0);
#pragma unroll
        for (int cb = 0; cb < 4; ++cb)
#pragma unroll
            for (int j = 0; j < 2; ++j) {
                const u32x4 sw = {pk(S[cb][8 * j], S[cb][8 * j + 1]), pk(S[cb][8 * j + 2], S[cb][8 * j + 3]), pk(S[cb][8 * j + 4], S[cb][8 * j + 5]), pk(S[cb][8 * j + 6], S[cb][8 * j + 7])};
                const bf16x8 sa = __builtin_bit_cast(bf16x8, sw);
#pragma unroll
                for (int tb = 0; tb < 2; ++tb) { const ldsp qp = L + QT_OFF + (32 * tb + r32) * QT_RS + (32 * cb + 16 * j + 4 * hi) * 2;
                    const u32x2 x0 = *(const GLDS u32x2*)qp, x1 = *(const GLDS u32x2*)(qp + 16);
                    const u32x4 qw = {x0.x, x0.y, x1.x, x1.y};
                    o[tb] = __builtin_amdgcn_mfma_f32_32x32x16_bf16(sa, __builtin_bit_cast(bf16x8, qw), o[tb], 0, 0, 0); }
                __builtin_amdgcn_sched_barrier(0);
            }
        }
#pragma unroll
        for (int cb = 0; cb < 4; ++cb) {
#pragma unroll
            for (int g = 0; g < 4; ++g) { const f32x4 e = *(const GLDS f32x4*)(EBL + 32 * cb + 8 * g + 4 * hi);
                S[cb][4 * g] *= e[0]; S[cb][4 * g + 1] *= e[1]; S[cb][4 * g + 2] *= e[2]; S[cb][4 * g + 3] *= e[3]; }
#pragma unroll
            for (int ks = 0; ks < 4; ++ks) { const bf16x8 kf = *(const GLDS bf16x8*)(L + KH_OFF + (32 * cb + r32) * KH_RS + (16 * ks + 8 * hi) * 2);
                S[cb] = __builtin_amdgcn_mfma_f32_32x32x16_bf16(kf, vf[ks], S[cb], 0, 0, 0); }
            __builtin_amdgcn_sched_barrier(0);
        }
        u32x2 rbv[2][4];
        if (MODE == 1) {
#pragma unroll
        for (int tb = 0; tb < 2; ++tb)
#pragma unroll
            for (int g = 0; g < 4; ++g) rbv[tb][g] = *(const u32x2*)((const char*)(RB + (row0 + 32 * tb) * 1024 + h * 256 + 32 * wid + 8 * g) + lor);
#pragma unroll
        for (int tb = 0; tb < 2; ++tb) { float ss = 0.f;
#pragma unroll
            for (int r = 0; r < 16; ++r) ss += o[tb][r] * o[tb][r];
            ss += __shfl_xor(ss, 32);
            if (hi == 0) SSQ[wid * 64 + 32 * tb + r32] = ss; }
        }
        GBAR();
        if (MODE == 1) {
#pragma unroll
        for (int tb = 0; tb < 2; ++tb) { float tot = 0.f;
#pragma unroll
            for (int w = 0; w < 8; ++w) tot += SSQ[w * 64 + 32 * tb + r32];
            const float rstd = 1.0f / sqrtf(tot * (1.0f / 256.0f) + LN_EPS);
#pragma unroll
            for (int g = 0; g < 4; ++g) { const u32x2 rw = rbv[tb][g];
                const float y0 = o[tb][4 * g] * rstd * bflo(rw.x), y1 = o[tb][4 * g + 1] * rstd * bfhi(rw.x);
                const float y2 = o[tb][4 * g + 2] * rstd * bflo(rw.y), y3 = o[tb][4 * g + 3] * rstd * bfhi(rw.y);
                *(u32x2*)((char*)(OB + (row0 + 32 * tb) * 1024 + h * 256 + 32 * wid + 8 * g) + lor) = (u32x2){pk(y0, y1), pk(y2, y3)}; } }
        }
    }
    if (MODE == 0) {
        float* sl = SLOC + ((size_t)((b * 4 + h) * 8 + seg) * 128) * 256;
#pragma unroll
        for (int cb = 0; cb < 4; ++cb)
#pragma unroll
            for (int r = 0; r < 16; ++r) sl[(size_t)(32 * cb + crow(r, hi)) * 256 + 32 * wid + r32] = S[cb][r];
        if (wid == 0) { float* dd = DTOT + ((b * 4 + h) * 8 + seg) * 128; dd[c0] = dt0; dd[c0 + 1] = dt1; }
    } else if (seg == 7) {
#pragma unroll
        for (int cb = 0; cb < 4; ++cb)
#pragma unroll
            for (int r = 0; r < 16; ++r) S_out[((size_t)(b * 4 + h) * 128 + 32 * cb + crow(r, hi)) * 256 + 32 * wid + r32] = S[cb][r];
    }
    GBAR();
#undef GLA_LOAD
}

__device__ __forceinline__ void sample_unit(int b, int h, const bf16_t* __restrict__ QB, const bf16_t* __restrict__ KB, const bf16_t* __restrict__ VB, bf16_t* __restrict__ OB, const bf16_t* __restrict__ RB, const float* __restrict__ A1,
                                            const float* __restrict__ w_a2, const float* __restrict__ b_a2, const float* __restrict__ g_gla, const float* __restrict__ S0, float* __restrict__ S_out, char* shm, const int wv) {
    const int tid = TIDX(wv), lane = tid & 63, wid = wv;
    GLDS float* Lf = (GLDS float*)shm;
    GLDS float* BQ = Lf; GLDS float* BK = Lf + 2048; GLDS float* KHs = Lf + 4096; GLDS float* EB = Lf + 6144; GLDS float* VL = Lf + 6272; GLDS float* AS = Lf + 10368; GLDS float* SQ = Lf + 10624;
    const long row0 = (long)MP + 16 * b;
    const float* S0h = S0 + (size_t)(b * 4 + h) * 128 * 256; float* SOh = S_out + (size_t)(b * 4 + h) * 128 * 256;
    if (tid < 128) { const int c = tid; float bc[16]; float run = 0.f;
#pragma unroll
        for (int t = 0; t < 16; ++t) { float z = b_a2[h * 128 + c];
#pragma unroll
            for (int r = 0; r < 16; ++r) z += A1[(row0 + t) * 16 + r] * w_a2[r * 512 + h * 128 + c];
            run += logsig(z) * 0.0625f; bc[t] = run; }
#pragma unroll
        for (int t = 0; t < 16; ++t) { const float q = __uint_as_float((unsigned)QB[(row0 + t) * 512 + h * 128 + c] << 16), k = __uint_as_float((unsigned)KB[(row0 + t) * 512 + h * 128 + c] << 16);
            BQ[t * 128 + c] = q * SCQ * __expf(bc[t]); BK[t * 128 + c] = k * __expf(-bc[t]); KHs[t * 128 + c] = k * __expf(run - bc[t]); }
        EB[c] = __expf(run); }
    for (int i = tid; i < 4096; i += 512) VL[i] = __uint_as_float((unsigned)VB[(row0 + (i >> 8)) * 1024 + h * 256 + (i & 255)] << 16);
    __syncthreads();
    if (tid < 256) { const int t = tid >> 4, s = tid & 15; float a = 0.f; if (s <= t) { for (int c = 0; c < 128; ++c) a += BQ[t * 128 + c] * BK[s * 128 + c]; } AS[tid] = a; }
    __syncthreads();
    const int v = tid & 255, th = tid >> 8;
    float o[8];
#pragma unroll
    for (int i = 0; i < 8; ++i) o[i] = 0.f;
    for (int s = 0; s < 16; ++s) { const float vv = VL[s * 256 + v];
#pragma unroll
        for (int i = 0; i < 8; ++i) o[i] += AS[(8 * th + i) * 16 + s] * vv; }
    for (int c = 0; c < 128; ++c) { const float s0 = S0h[c * 256 + v];
#pragma unroll
        for (int i = 0; i < 8; ++i) o[i] += BQ[(8 * th + i) * 128 + c] * s0; }
#pragma unroll
    for (int i = 0; i < 8; ++i) { float ss = o[i] * o[i];
#pragma unroll
        for (int d = 1; d < 64; d <<= 1) ss += __shfl_xor(ss, d);
        if (lane == 0) SQ[(8 * th + i) * 4 + (wid & 3)] = ss; }
    __syncthreads();
#pragma unroll
    for (int i = 0; i < 8; ++i) { const int t = 8 * th + i; const float tot = SQ[t * 4] + SQ[t * 4 + 1] + SQ[t * 4 + 2] + SQ[t * 4 + 3];
        const float rstd = 1.0f / sqrtf(tot * (1.0f / 256.0f) + LN_EPS);
        const float r = __uint_as_float((unsigned)RB[(row0 + t) * 1024 + h * 256 + v] << 16);
        const float y = o[i] * rstd * r;
        OB[(row0 + t) * 1024 + h * 256 + v] = (bf16_t)(pk(y, 0.f) & 0xffffu); }
    for (int cc = 0; cc < 64; ++cc) { const int c = 64 * th + cc; float s = EB[c] * S0h[c * 256 + v];
#pragma unroll
        for (int t = 0; t < 16; ++t) s += KHs[t * 128 + c] * VL[t * 256 + v];
        SOh[c * 256 + v] = s; }
    __syncthreads();
}
#undef GBAR
}
namespace sattn {
typedef unsigned short bf16_t;
typedef short bf16x8 __attribute__((ext_vector_type(8)));
typedef float f32x4 __attribute__((ext_vector_type(4)));
typedef unsigned u32x4 __attribute__((ext_vector_type(4)));
#define SLDS __attribute__((address_space(3)))
constexpr int PAST = 2048, NKEY = 2064, NBLK = 65;
__device__ __forceinline__ unsigned pk(float lo, float hi) { return gla::pk(lo, hi); }
__device__ __forceinline__ void unit(int b, int h, const bf16_t* __restrict__ QA, bf16_t* OA, const float* __restrict__ cK, const float* __restrict__ cV, const float* __restrict__ cF,
                                     const float* __restrict__ out, char* shm, const int wv) {
    const int tid = TIDX(wv), lane = tid & 63, wid = wv, l15 = lane & 15, kq = lane >> 4;
    SLDS float* CB = (SLDS float*)shm;
    SLDS float* CM = CB + 2600;
    {
        const int j0 = 5 * tid; float sv[5]; float run = 0.f;
#pragma unroll
        for (int i = 0; i < 5; ++i) { const int j = j0 + i; float lf = 0.f;
            if (j < PAST) lf = cF[((size_t)b * PAST + j) * 8 + h]; else if (j < NKEY) lf = out[O_FS + ((size_t)b * 16 + (j - PAST)) * 8 + h];
            run += lf; sv[i] = run; }
        float incl = run;
#pragma unroll
        for (int o_ = 1; o_ < 64; o_ <<= 1) { const float n_ = __shfl_up(incl, o_); if (lane >= o_) incl += n_; }
        if (lane == 63) CB[2560 + wid] = incl;
        __syncthreads();
        float wp = 0.f;
#pragma unroll
        for (int w_ = 0; w_ < 8; ++w_) { const float x_ = CB[2560 + w_]; if (w_ < wid) wp += x_; }
        const float off_ = wp + incl - run;
#pragma unroll
        for (int i = 0; i < 5; ++i) CB[j0 + i] = -(off_ + sv[i]) * 1.4426950408889634f;
        __syncthreads();
    }
    const long qrow = (long)MP + 16 * b + l15;
    const bf16x8 qf0 = *(const bf16x8*)(QA + qrow * 512 + h * 64 + 8 * kq), qf1 = *(const bf16x8*)(QA + qrow * 512 + h * 64 + 32 + 8 * kq);
    float m_run = -1e30f, l_run = 0.f; f32x4 O[4];
#pragma unroll
    for (int i = 0; i < 4; ++i) O[i] = (f32x4){0.f, 0.f, 0.f, 0.f};
    for (int blk = wid; blk < NBLK; blk += 8) {
        const int key0 = 32 * blk;
        f32x4 st[2];
#pragma unroll
        for (int e = 0; e < 2; ++e) { int key = key0 + 16 * e + l15; if (key > NKEY - 1) key = NKEY - 1;
            const float* kp = key < PAST ? cK + (((size_t)b * PAST + key) * 8 + h) * 64 : out + O_KS + (((size_t)b * 16 + (key - PAST)) * 8 + h) * 64;
            const f32x4 a0 = *(const f32x4*)(kp + 8 * kq), a1 = *(const f32x4*)(kp + 8 * kq + 4), a2 = *(const f32x4*)(kp + 32 + 8 * kq), a3 = *(const f32x4*)(kp + 32 + 8 * kq + 4);
            const u32x4 w0 = {pk(a0[0], a0[1]), pk(a0[2], a0[3]), pk(a1[0], a1[1]), pk(a1[2], a1[3])}, w1 = {pk(a2[0], a2[1]), pk(a2[2], a2[3]), pk(a3[0], a3[1]), pk(a3[2], a3[3])};
            f32x4 s = {0.f, 0.f, 0.f, 0.f};
            s = __builtin_amdgcn_mfma_f32_16x16x32_bf16(__builtin_bit_cast(bf16x8, w0), qf0, s, 0, 0, 0);
            s = __builtin_amdgcn_mfma_f32_16x16x32_bf16(__builtin_bit_cast(bf16x8, w1), qf1, s, 0, 0, 0);
            st[e] = s; }
        float mx = -1e30f;
#pragma unroll
        for (int e = 0; e < 2; ++e)
#pragma unroll
            for (int i = 0; i < 4; ++i) { const int key = key0 + 16 * e + 4 * kq + i; float v = st[e][i] + CB[key]; if (key - PAST > l15) v = -1e30f; st[e][i] = v; mx = fmaxf(mx, v); }
        mx = fmaxf(mx, __shfl_xor(mx, 16)); mx = fmaxf(mx, __shfl_xor(mx, 32));
        const float mnew = fmaxf(m_run, mx), f = exp2f(m_run - mnew); m_run = mnew;
        float ps = 0.f; float p[2][4];
#pragma unroll
        for (int e = 0; e < 2; ++e)
#pragma unroll
            for (int i = 0; i < 4; ++i) { const float pv = (st[e][i] <= -1e29f) ? 0.f : exp2f(st[e][i] - mnew); p[e][i] = pv; ps += pv; }
        l_run = l_run * f + ps;
#pragma unroll
        for (int d = 0; d < 4; ++d) O[d] *= f;
        const u32x4 pw = {pk(p[0][0], p[0][1]), pk(p[0][2], p[0][3]), pk(p[1][0], p[1][1]), pk(p[1][2], p[1][3])};
        const bf16x8 pB = __builtin_bit_cast(bf16x8, pw);
        float vv[4][8];
#pragma unroll
        for (int sl = 0; sl < 8; ++sl) { int key = key0 + 16 * (sl >> 2) + 4 * kq + (sl & 3); if (key > NKEY - 1) key = NKEY - 1;
            const float* vp = key < PAST ? cV + (((size_t)b * PAST + key) * 8 + h) * 64 : out + O_VS + (((size_t)b * 16 + (key - PAST)) * 8 + h) * 64;
#pragma unroll
            for (int db = 0; db < 4; ++db) vv[db][sl] = vp[16 * db + l15]; }
#pragma unroll
        for (int db = 0; db < 4; ++db) { const u32x4 vw = {pk(vv[db][0], vv[db][1]), pk(vv[db][2], vv[db][3]), pk(vv[db][4], vv[db][5]), pk(vv[db][6], vv[db][7])};
            O[db] = __builtin_amdgcn_mfma_f32_16x16x32_bf16(__builtin_bit_cast(bf16x8, vw), pB, O[db], 0, 0, 0); }
    }
    l_run += __shfl_xor(l_run, 16); l_run += __shfl_xor(l_run, 32);
    SLDS float* cw = CM + wid * 1056;
    if (kq == 0) { cw[l15] = m_run; cw[16 + l15] = l_run; }
#pragma unroll
    for (int db = 0; db < 4; ++db)
#pragma unroll
        for (int i = 0; i < 4; ++i) cw[32 + (16 * db + 4 * kq + i) * 16 + l15] = O[db][i];
    __syncthreads();
    { const int q = tid >> 5, d0 = 2 * (tid & 31);
        float M = -1e30f;
#pragma unroll
        for (int w = 0; w < 8; ++w) M = fmaxf(M, CM[w * 1056 + q]);
        float Ls = 0.f, o0 = 0.f, o1 = 0.f;
#pragma unroll
        for (int w = 0; w < 8; ++w) { const float sc = exp2f(CM[w * 1056 + q] - M); Ls += CM[w * 1056 + 16 + q] * sc; o0 += CM[w * 1056 + 32 + d0 * 16 + q] * sc; o1 += CM[w * 1056 + 32 + (d0 + 1) * 16 + q] * sc; }
        const float inv = 1.0f / Ls;
        *(unsigned*)(OA + ((long)MP + 16 * b + q) * 512 + h * 64 + d0) = pk(o0 * inv, o1 * inv); }
    __syncthreads();
}
}
namespace cg = cooperative_groups;
typedef unsigned short bf16;
#define LAS __attribute__((address_space(3)))
typedef unsigned v4u __attribute__((ext_vector_type(4)));
typedef float f32x4 __attribute__((ext_vector_type(4)));
constexpr size_t MiB = 1u << 20;
constexpr size_t WS_CTL = 0, WS_WIN = 1 * MiB, WS_WAO = 15 * MiB, WS_WBO = 16 * MiB, WS_WO = 18 * MiB, WS_WUP = 20 * MiB, WS_WDN = 31 * MiB, WS_WPLG = 37 * MiB, WS_WPL = 39 * MiB, WS_A1 = 40 * MiB, WS_CBG = 45 * MiB;
constexpr size_t WS_XB = 48 * MiB;
constexpr size_t WS_QA = 177 * MiB, WS_KA = 242 * MiB, WS_VA = 307 * MiB, WS_QB = 372 * MiB, WS_KB = 437 * MiB, WS_VB = 502 * MiB, WS_RB = 631 * MiB, WS_GB = 760 * MiB, WS_PB = 889 * MiB;
constexpr size_t WS_OA = 922 * MiB, WS_SLOC = 988 * MiB, WS_DTOT = 1020 * MiB;
constexpr size_t WS_UP = 177 * MiB, WS_H = 531 * MiB, WS_ZB = 177 * MiB, WS_TMP = 307 * MiB;
constexpr int RING_BYTES = 131072, MISC_OFF = RING_BYTES + 320, LDS_BYTES = 147456;
static_assert(attn_body::ATTN_LDS_BYTES <= RING_BYTES && gla::GLA_LDS_BYTES <= RING_BYTES, "phase scratch fits the ring");

__device__ __forceinline__ unsigned f2bf(float f) { unsigned u = __builtin_bit_cast(unsigned, f); return (u + 0x7fffu + ((u >> 16) & 1u)) >> 16; }
__device__ __forceinline__ unsigned pk2(float lo, float hi) { return f2bf(lo) | (f2bf(hi) << 16); }
__device__ __forceinline__ float wave_sum(float v) {
#pragma unroll
    for (int o = 1; o < 64; o <<= 1) v += __shfl_xor(v, o);
    return v;
}
__device__ __forceinline__ int map_win(int d) {
    if (d < 1536) return d;
    if (d < 2560) return 1544 + (d - 1536);
    if (d < 3584) return 2568 + (d - 2560);
    if (d < 4608) return 3592 + (d - 3584);
    if (d < 5632) return 4632 + (d - 4608);
    if (d < 6656) return 5656 + (d - 5632);
    if (d < 6664) return 1536 + (d - 6656);
    if (d < 6680) return 4616 + (d - 6664);
    return -1;
}
__device__ __forceinline__ int map_wup(int d) { const int j = d >> 8, l = d & 255; return l < 128 ? 128 * j + l : DFF + 128 * j + (l - 128); }
template <int MAP> __device__ __forceinline__ void transpose_item(const float* W, int K, int N, bf16* WT, LAS float* scr, int item, int nblk, int lane) {
    const int kb = item / nblk, nb = item % nblk, k0 = 64 * kb, n0 = 32 * nb;
    const int d = n0 + (lane & 31); const int sc = MAP == 1 ? map_win(d) : MAP == 2 ? map_wup(d) : d;
#pragma unroll 8
    for (int i = 0; i < 32; ++i) { const int kk = 2 * i + (lane >> 5); scr[kk * 33 + (lane & 31)] = sc >= 0 ? W[(size_t)(k0 + kk) * N + sc] : 0.f; }
    asm volatile("s_waitcnt lgkmcnt(0)" ::: "memory");
    const int c = lane & 7;
#pragma unroll
    for (int j = 0; j < 4; ++j) { const int n = (lane >> 3) + 8 * j; const LAS float* s = scr + (8 * c) * 33 + n;
        v4u o; o.x = pk2(s[0 * 33], s[1 * 33]); o.y = pk2(s[2 * 33], s[3 * 33]); o.z = pk2(s[4 * 33], s[5 * 33]); o.w = pk2(s[6 * 33], s[7 * 33]);
        *(v4u*)(WT + (size_t)(n0 + n) * K + k0 + 8 * c) = o; }
    asm volatile("s_waitcnt lgkmcnt(0)" ::: "memory");
}
template <int NR> __device__ __forceinline__ void ln_rows(const bf16* (&zr)[NR], bf16* (&ob)[NR], float* (&of)[NR], const float* g, const float* bt, int lane) {
    f32x4 v[NR][4];
#pragma unroll
    for (int r = 0; r < NR; ++r) { const v4u w0 = __builtin_nontemporal_load((const v4u*)zr[r] + lane), w1 = __builtin_nontemporal_load((const v4u*)zr[r] + 64 + lane); epi::unpack8(w0, v[r][0], v[r][1]); epi::unpack8(w1, v[r][2], v[r][3]); }
    f32x4 gg[4], bb[4];
#pragma unroll
    for (int j = 0; j < 4; ++j) { gg[j] = *((const f32x4*)g + (j >> 1) * 128 + 2 * lane + (j & 1)); bb[j] = *((const f32x4*)bt + (j >> 1) * 128 + 2 * lane + (j & 1)); }
#pragma unroll
    for (int r = 0; r < NR; ++r) { float s = 0.f;
#pragma unroll
        for (int j = 0; j < 4; ++j) s += (v[r][j].x + v[r][j].y) + (v[r][j].z + v[r][j].w);
        const float mean = wave_sum(s) * (1.f / 1024.f); float s2 = 0.f;
#pragma unroll
        for (int j = 0; j < 4; ++j) { v[r][j] = v[r][j] - mean; s2 += (v[r][j].x * v[r][j].x + v[r][j].y * v[r][j].y) + (v[r][j].z * v[r][j].z + v[r][j].w * v[r][j].w); }
        const float rstd = 1.f / sqrtf(wave_sum(s2) * (1.f / 1024.f) + LN_EPS);
#pragma unroll
        for (int j = 0; j < 4; ++j) v[r][j] = v[r][j] * rstd * gg[j] + bb[j];
        if (ob[r]) { *((v4u*)ob[r] + lane) = epi::pack8(v[r][0], v[r][1]); *((v4u*)ob[r] + 64 + lane) = epi::pack8(v[r][2], v[r][3]); }
        if (of[r]) { f32x4* o = (f32x4*)of[r]; __builtin_nontemporal_store(v[r][0], o + 2 * lane); __builtin_nontemporal_store(v[r][1], o + 2 * lane + 1); __builtin_nontemporal_store(v[r][2], o + 128 + 2 * lane); __builtin_nontemporal_store(v[r][3], o + 128 + 2 * lane + 1); } }
}
__device__ __forceinline__ void ln_phase(const bf16* Z, bf16* OB, float* OF, const float* g, const float* bt, int gw, int NGW, int lane) {
    for (int m = gw; m < MROWS; m += 4 * NGW) {
        if (m + 3 * NGW < MROWS) { const bf16* zr[4]; bf16* ob[4]; float* of[4];
#pragma unroll
            for (int r = 0; r < 4; ++r) { const size_t o = (size_t)(m + r * NGW) * 1024; zr[r] = Z + o; ob[r] = OB ? OB + o : nullptr; of[r] = OF ? OF + o : nullptr; }
            ln_rows<4>(zr, ob, of, g, bt, lane); }
        else { for (int r = 0; r < 4; ++r) { const int mm = m + r * NGW; if (mm < MROWS) { const bf16* zr[1] = {Z + (size_t)mm * 1024}; bf16* ob[1] = {OB ? OB + (size_t)mm * 1024 : nullptr}; float* of[1] = {OF ? OF + (size_t)mm * 1024 : nullptr}; ln_rows<1>(zr, ob, of, g, bt, lane); } } } }
}
__device__ __forceinline__ float gelu_tanh(float x) { const float u = 0.7978845608028654f * (x + 0.044715f * x * x * x); const float e = __expf(2.f * u); return 0.5f * x * (2.f - 2.f * __builtin_amdgcn_rcpf(1.f + e)); }
__device__ __forceinline__ void conv_phase(const bf16* __restrict__ UP, bf16* __restrict__ H, const float* __restrict__ cw, const float* __restrict__ cbias, const float* __restrict__ cprev, int half, int gw, int NGW, int lane) {
    const int cgp = lane & 15, rs = lane >> 4;
    for (int it = gw; it < (MROWS / 64) * 11; it += NGW) {
        const int jl = it % 11, run = it / 11, jg = half * 11 + jl, r0 = run * 64 + 16 * rs;
        const int colv = 128 * jg + 8 * cgp, colg = DFF + colv;
        float w0v[8], w1v[8], w2v[8], bv[8], w0g[8], w1g[8], w2g[8], bg[8];
#pragma unroll
        for (int i = 0; i < 8; ++i) { w0v[i] = cw[colv + i]; w1v[i] = cw[5632 + colv + i]; w2v[i] = cw[2 * 5632 + colv + i]; bv[i] = cbias[colv + i];
            w0g[i] = cw[colg + i]; w1g[i] = cw[5632 + colg + i]; w2g[i] = cw[2 * 5632 + colg + i]; bg[i] = cbias[colg + i]; }
        float v2[8], v1[8], g2[8], g1[8];
        const bf16* up = UP + (size_t)r0 * DFF + 256 * jl + 8 * cgp;
        if (r0 < MP && (r0 & (TSEQ - 1)) != 0) { f32x4 a, b;
            epi::unpack8(*(const v4u*)(up - 2 * DFF), a, b); v2[0] = a[0]; v2[1] = a[1]; v2[2] = a[2]; v2[3] = a[3]; v2[4] = b[0]; v2[5] = b[1]; v2[6] = b[2]; v2[7] = b[3];
            epi::unpack8(*(const v4u*)(up - DFF), a, b); v1[0] = a[0]; v1[1] = a[1]; v1[2] = a[2]; v1[3] = a[3]; v1[4] = b[0]; v1[5] = b[1]; v1[6] = b[2]; v1[7] = b[3];
            epi::unpack8(*(const v4u*)(up - 2 * DFF + 128), a, b); g2[0] = a[0]; g2[1] = a[1]; g2[2] = a[2]; g2[3] = a[3]; g2[4] = b[0]; g2[5] = b[1]; g2[6] = b[2]; g2[7] = b[3];
            epi::unpack8(*(const v4u*)(up - DFF + 128), a, b); g1[0] = a[0]; g1[1] = a[1]; g1[2] = a[2]; g1[3] = a[3]; g1[4] = b[0]; g1[5] = b[1]; g1[6] = b[2]; g1[7] = b[3];
        } else if (r0 >= MP) { const float* cp = cprev + (size_t)((r0 - MP) >> 4) * 2 * 5632;
#pragma unroll
            for (int i = 0; i < 8; ++i) { v2[i] = cp[colv + i]; v1[i] = cp[5632 + colv + i]; g2[i] = cp[colg + i]; g1[i] = cp[5632 + colg + i]; }
        } else {
#pragma unroll
            for (int i = 0; i < 8; ++i) { v2[i] = 0.f; v1[i] = 0.f; g2[i] = 0.f; g1[i] = 0.f; }
        }
        bf16* hp = H + (size_t)r0 * DFF + colv;
#pragma unroll 4
        for (int t = 0; t < 16; ++t) { f32x4 a, b, c, d; epi::unpack8(__builtin_nontemporal_load((const v4u*)(up + (size_t)t * DFF)), a, b); epi::unpack8(__builtin_nontemporal_load((const v4u*)(up + (size_t)t * DFF + 128)), c, d);
            const float cv[8] = {a[0], a[1], a[2], a[3], b[0], b[1], b[2], b[3]}, cgt[8] = {c[0], c[1], c[2], c[3], d[0], d[1], d[2], d[3]};
            float o[8];
#pragma unroll
            for (int i = 0; i < 8; ++i) { const float val = bv[i] + w0v[i] * v2[i] + w1v[i] * v1[i] + w2v[i] * cv[i]; const float gt = bg[i] + w0g[i] * g2[i] + w1g[i] * g1[i] + w2g[i] * cgt[i];
                o[i] = val * gelu_tanh(gt); v2[i] = v1[i]; v1[i] = cv[i]; g2[i] = g1[i]; g1[i] = cgt[i]; }
            v4u w; w.x = pk2(o[0], o[1]); w.y = pk2(o[2], o[3]); w.z = pk2(o[4], o[5]); w.w = pk2(o[6], o[7]);
            __builtin_nontemporal_store(w, (v4u*)(hp + (size_t)t * DFF)); }
    }
}

#define XB_TMO      128
#define XB_XCNT(j)  (256  + 64 * (j))
#define XB_XSUB(j)  (1280 + 64 * (j))
#define XB_XGEN(j)  (2304 + 64 * (j))
#define XB_TOP      3328
#define XB_TOPGEN   3392
#define XCD_BAR_WORDS 3456
#define XB_SPIN_CAP (1u << 18)

__device__ __forceinline__ unsigned xb_ld(unsigned* p)              { return __hip_atomic_load(p, __ATOMIC_RELAXED, __HIP_MEMORY_SCOPE_AGENT); }
__device__ __forceinline__ unsigned xb_add(unsigned* p, unsigned v) { return __hip_atomic_fetch_add(p, v, __ATOMIC_RELAXED, __HIP_MEMORY_SCOPE_AGENT); }
__device__ __forceinline__ unsigned xb_xcc_id() { return (unsigned)__builtin_amdgcn_s_getreg((3 << 11) | 20) & 0xFu; }
#define XB_SPIN(cond, bar) do { unsigned _sp = 0; while (cond) { __builtin_amdgcn_s_sleep(1); \
    if ((++_sp & 255u) == 0u) { if (xb_ld(&(bar)[XB_TMO])) break; if (_sp > XB_SPIN_CAP) { atomicAdd(&(bar)[XB_TMO], 1u); break; } } } } while (0)

struct XcdBarrier {
    unsigned* bar; unsigned x;
    volatile LAS unsigned* st;
};

__device__ __forceinline__ XcdBarrier xcd_barrier_post(unsigned* bar, volatile LAS unsigned* st, bool t0) {
    XcdBarrier b; b.bar = bar; b.x = xb_xcc_id(); b.st = st;
    if (t0) (void)xb_add(&bar[XB_XCNT(b.x)], 1u);
    return b;
}
__device__ __forceinline__ void xcd_barrier_complete(unsigned* bar, unsigned x, unsigned& nloc, unsigned& nx) {
    const unsigned G = gridDim.x * gridDim.y * gridDim.z;
    unsigned sum, cnt, mine, sp = 0u;
    for (;;) {
        sum = 0u; cnt = 0u; mine = 0u;
#pragma unroll
        for (unsigned j = 0; j < 16; ++j) { const unsigned c = xb_ld(&bar[XB_XCNT(j)]); sum += c; cnt += (c > 0u) ? 1u : 0u; mine = (j == x) ? c : mine; }
        if (sum == G) break;
        __builtin_amdgcn_s_sleep(1);
        if ((++sp & 255u) == 0u) { if (xb_ld(&bar[XB_TMO])) break; if (sp > XB_SPIN_CAP) { atomicAdd(&bar[XB_TMO], 1u); break; } }
    }
    nloc = mine > 0u ? mine : 1u; nx = cnt > 0u ? cnt : 1u;
}

__device__ __forceinline__ void xcd_barrier(const XcdBarrier& b, bool t0) {
    asm volatile("s_waitcnt vmcnt(0)" ::: "memory");
    __syncthreads();
    if (t0) {
        unsigned* bar = b.bar;
        __builtin_amdgcn_s_waitcnt(0);
        unsigned nloc = b.st[0], nx = b.st[1];
        if (nloc == 0u) { xcd_barrier_complete(bar, b.x, nloc, nx); b.st[0] = nloc; b.st[1] = nx; }
        const unsigned old = xb_add(&bar[XB_XSUB(b.x)], 1u);
        const unsigned gen = old / nloc;
        if (old + 1u == (gen + 1u) * nloc) {
            __builtin_amdgcn_fence(__ATOMIC_RELEASE, "agent");
            asm volatile("s_waitcnt vmcnt(0)" ::: "memory");
            const unsigned og = xb_add(&bar[XB_TOP], 1u);
            const unsigned tg = og / nx;
            if (og + 1u == (tg + 1u) * nx) xb_add(&bar[XB_TOPGEN], 1u);
            else XB_SPIN(xb_ld(&bar[XB_TOPGEN]) == tg, bar);
            __builtin_amdgcn_fence(__ATOMIC_ACQUIRE, "agent");
            xb_add(&bar[XB_XGEN(b.x)], 1u);
            asm volatile("s_waitcnt vmcnt(0)" ::: "memory");
        } else {
            XB_SPIN(xb_ld(&bar[XB_XGEN(b.x)]) == gen, bar);
            __builtin_amdgcn_fence(__ATOMIC_ACQUIRE, "agent");
            asm volatile("s_waitcnt vmcnt(0)" ::: "memory");
        }
    }
    __syncthreads();
}

struct Args { const float* in[29]; float* out; unsigned char* ws; int ph_lo, ph_hi; };
#define KAS __attribute__((address_space(4)))
__device__ __forceinline__ const float* karg(int i) { const KAS char* ka = (const KAS char*)__builtin_amdgcn_kernarg_segment_ptr(); const unsigned long long v = *(const unsigned long long volatile KAS*)(ka + 8 * i); return (const float*)(const __attribute__((address_space(1))) float*)v; }
__device__ __forceinline__ int kargi(int byteoff) { const KAS char* ka = (const KAS char*)__builtin_amdgcn_kernarg_segment_ptr(); return *(const int volatile KAS*)(ka + byteoff); }
constexpr int N_PHASES = 14;
__global__ void __launch_bounds__(512, 2) fwd_kernel(Args args) {
    extern __shared__ __attribute__((aligned(16))) unsigned char lds[];
    LAS unsigned char* ldsl = (LAS unsigned char*)lds;
    volatile LAS unsigned* MISC = (volatile LAS unsigned*)(ldsl + MISC_OFF);
    const int wave = __builtin_amdgcn_readfirstlane((int)threadIdx.x >> 6);
#define lane lane_id_asm()
#define tid TIDX(wave)
    const int G = gridDim.x, bx = blockIdx.x; const int vcu = (G % 8 == 0) ? (bx % 8) * (G / 8) + bx / 8 : bx;
    const int gw = vcu * 8 + wave, NGW = G * 8;
    if (TIDX(wave) < 32) MISC[TIDX(wave)] = 0u;
    __syncthreads();
    XcdBarrier xbar = xcd_barrier_post((unsigned*)(karg(30)) + 4096, MISC + 8, TIDX(wave) == 0);
#define GSYNC() xcd_barrier(xbar, TIDX(wave) == 0)
#define x_p karg(0)
#define x_s karg(1)
#define cK karg(2)
#define cV karg(3)
#define cF karg(4)
#define S0 karg(5)
#define cconv karg(6)
#define p_p karg(7)
#define p_s karg(8)
#define w_in karg(9)
#define b_fg karg(10)
#define w_a2 karg(11)
#define b_a2 karg(12)
#define g_gla karg(13)
#define w_ao karg(14)
#define w_bo karg(15)
#define w_o karg(16)
#define ln1g karg(17)
#define ln1b karg(18)
#define w_up karg(19)
#define conv_w karg(20)
#define conv_b karg(21)
#define w_dn karg(22)
#define ln2g karg(23)
#define ln2b karg(24)
#define w_pl karg(25)
#define w_plg karg(26)
#define ln3g karg(27)
#define ln3b karg(28)
#define out ((float*)karg(29))
#define ws ((unsigned char*)karg(30))
#define Win ((bf16*)(ws + WS_WIN))
#define Wao ((bf16*)(ws + WS_WAO))
#define Wbo ((bf16*)(ws + WS_WBO))
#define Wo ((bf16*)(ws + WS_WO))
#define Wup ((bf16*)(ws + WS_WUP))
#define Wdn ((bf16*)(ws + WS_WDN))
#define Wplg ((bf16*)(ws + WS_WPLG))
#define Wpl ((bf16*)(ws + WS_WPL))
#define A1 ((float*)(ws + WS_A1))
#define XB ((bf16*)(ws + WS_XB))
#define QA ((bf16*)(ws + WS_QA))
#define KA ((bf16*)(ws + WS_KA))
#define VA ((bf16*)(ws + WS_VA))
#define QB ((bf16*)(ws + WS_QB))
#define KB ((bf16*)(ws + WS_KB))
#define VB ((bf16*)(ws + WS_VB))
#define RB ((bf16*)(ws + WS_RB))
#define GB ((bf16*)(ws + WS_GB))
#define PB ((bf16*)(ws + WS_PB))
#define OA ((bf16*)(ws + WS_OA))
#define OBG XB
#define MG VB
#define GA ((bf16*)out)
#define UP ((bf16*)(ws + WS_UP))
#define HB ((bf16*)(ws + WS_H))
#define TMP ((bf16*)(ws + WS_TMP))
#define ZB ((bf16*)(ws + WS_ZB))
#define Y (out + O_Y)
    const int lo = kargi(31 * 8), hi = kargi(31 * 8 + 4);
#ifndef PH_MASK
#define PH_MASK 0xffff
#endif
#define IN(k) (((PH_MASK >> (k)) & 1) && lo <= (k) && (k) < hi)
#ifndef REPEAT_MASK
#define REPEAT_MASK 0
#endif
#define NREP(k) ((((REPEAT_MASK) >> (k)) & 1) + 1)
#define SEAM(k) do { if (IN(k) && IN((k) + 1)) { if ((k) == 0) cg::this_grid().sync(); else GSYNC(); } } while (0)

    for (int rep = 0; rep < NREP(0); ++rep) if (IN(0)) {
        LAS float* scr = (LAS float*)(ldsl + wave * 16384);
        constexpr int I0 = 16 * 216, I1 = 8 * 32, I2 = 16 * 32, I3 = 16 * 32, I4 = 16 * 32, I5 = 16 * 176, I6 = 44 * 32, I7 = 4 * 32;
        constexpr int NIT = I0 + I1 + I2 + I3 + I4 + I5 + I6 + I7;
        for (int it = gw; it < NIT; it += NGW) {
            int r = it;
            if (r < I0) { transpose_item<1>(w_in, 1024, 6680, Win, scr, r, 216, lane); continue; } r -= I0;
            if (r < I1) { transpose_item<0>(w_ao, 512, 1024, Wao, scr, r, 32, lane); continue; } r -= I1;
            if (r < I2) { transpose_item<0>(w_bo, 1024, 1024, Wbo, scr, r, 32, lane); continue; } r -= I2;
            if (r < I3) { transpose_item<0>(w_o, 1024, 1024, Wo, scr, r, 32, lane); continue; } r -= I3;
            if (r < I4) { transpose_item<0>(w_plg, 1024, 1024, Wplg, scr, r, 32, lane); continue; } r -= I4;
            if (r < I5) { transpose_item<2>(w_up, 1024, 5632, Wup, scr, r, 176, lane); continue; } r -= I5;
            if (r < I6) { transpose_item<0>(w_dn, 2816, 1024, Wdn, scr, r, 32, lane); continue; } r -= I6;
            transpose_item<0>(w_pl, 256, 1024, Wpl, scr, r, 32, lane);
        }
        for (int m0 = gw; m0 < MROWS; m0 += 4 * NGW) {
            f32x4 v[4][4], pv[4];
#pragma unroll
            for (int r = 0; r < 4; ++r) { const int m = m0 + r * NGW; if (m < MROWS) {
                const float* xr = m < MP ? x_p + (size_t)m * 1024 : x_s + (size_t)(m - MP) * 1024; const float* pr = m < MP ? p_p + (size_t)m * 256 : p_s + (size_t)(m - MP) * 256;
#pragma unroll
                for (int j = 0; j < 4; ++j) v[r][j] = __builtin_nontemporal_load((const f32x4*)xr + lane + 64 * j);
                pv[r] = __builtin_nontemporal_load((const f32x4*)pr + lane); } }
#pragma unroll
            for (int r = 0; r < 4; ++r) { const int m = m0 + r * NGW; if (m < MROWS) {
                unsigned long long* o8 = (unsigned long long*)(XB + (size_t)m * 1024) + lane;
#pragma unroll
                for (int j = 0; j < 4; ++j) o8[64 * j] = (unsigned long long)pk2(v[r][j].x, v[r][j].y) | ((unsigned long long)pk2(v[r][j].z, v[r][j].w) << 32);
                *((unsigned long long*)(PB + (size_t)m * 256) + lane) = (unsigned long long)pk2(pv[r].x, pv[r].y) | ((unsigned long long)pk2(pv[r].z, pv[r].w) << 32); } }
        }
    }
    SEAM(0);
#ifdef EXTRA_SYNCS
    for (int e_ = 0; e_ < EXTRA_SYNCS; ++e_) GSYNC();
#endif
    for (int rep = 0; rep < NREP(1); ++rep) if (IN(1)) {
        pg8::Gemm g{XB, Win, MP, 6912, 1024}; pg8::StaticOrder S; S.init(MP, 6912, G, bx);
        epi::EpiProj E{QA, KA, VA, QB, KB, VB, RB, GA, GB, A1, out, b_fg, (unsigned*)(ws + WS_CTL) + 128, g_gla};
        epi::light_gemm_wide(XB, Win, 6912, 1024, E, wave, bx, G, ldsl);
        pg8::gemm_phase<epi::EpiProj, pg8::StaticOrder, true, true>(ldsl, g, S, E, wave);
    }
    SEAM(1);
    for (int rep = 0; rep < NREP(2); ++rep) { if (rep) GSYNC(); if (IN(2)) {
#ifndef MIX_MASK
#define MIX_MASK 15
#endif
#ifndef REP2_MIX
#define REP2_MIX 15
#endif
        const int mixm = rep ? (REP2_MIX) : (MIX_MASK);
        if (mixm & 2) { for (int c = bx; c < 64; c += G) attn_body::cb_scan(c >> 3, c & 7, out + O_FP, (float*)(ws + WS_CBG), (char*)lds, wave); }
        if (mixm & 1) {
            for (int it = bx; it < 224; it += G) gla::chain<0>((it & 31) >> 2, it & 3, it >> 5, (float*)(ws + WS_SLOC), (float*)(ws + WS_DTOT), QB, KB, VB, OBG, RB, A1, w_a2, b_a2, g_gla, out + O_SP, (char*)lds, wave);
            if (bx >= 224 || G < 256) {
                const int nb = G < 256 ? G : G - 224, b0 = G < 256 ? bx : bx - 224;
                if (mixm & 4) { for (int u = b0; u < 64; u += nb) sattn::unit(u >> 3, u & 7, QA, OA, cK, cV, cF, out, (char*)lds, wave); }
                if (mixm & 8) { for (int u = b0; u < 32; u += nb) gla::sample_unit(u >> 2, u & 3, QB, KB, VB, OBG, RB, A1, w_a2, b_a2, g_gla, S0, out + O_SS, (char*)lds, wave); } }
            GSYNC();
            for (int it = bx; it < 256; it += G) gla::chain<1>((it & 31) >> 2, it & 3, it >> 5, (float*)(ws + WS_SLOC), (float*)(ws + WS_DTOT), QB, KB, VB, OBG, RB, A1, w_a2, b_a2, g_gla, out + O_SP, (char*)lds, wave); }
        if (mixm & 2) { unsigned* qctr = (unsigned*)(ws + WS_CTL) + 64 * rep;
            const attn_body::bf16 *qa_ = (const attn_body::bf16*)QA, *ka_ = (const attn_body::bf16*)KA, *va_ = (const attn_body::bf16*)VA; const float* lf_ = (const float*)(ws + WS_CBG);
            for (;;) {
                if (tid == 0) MISC[0] = atomicAdd(qctr, 1u);
                __syncthreads();
                const int u = __builtin_amdgcn_readfirstlane((int)MISC[0]);
                __syncthreads();
                if (u >= 2048) break;
                attn_body::attn_unit<60>((u & 63) >> 3, u & 7, 31 - (u >> 6), qa_, ka_, va_, (attn_body::bf16*)OA, lf_, (const float*)(ws + WS_CTL) + 128, (char*)lds, wave);
            } }
    } }
    SEAM(2);
    for (int rep = 0; rep < NREP(3); ++rep) if (IN(3)) {
        { pg8::Gemm g{OA, Wao, MP, 1024, 512}; pg8::StaticOrder S; S.init(MP, 1024, G, bx); epi::EpiMerge<0> E{GA, MG}; epi::light_gemm(OA, Wao, 1024, 512, E, wave, bx, G, ldsl);
          pg8::gemm_phase<epi::EpiMerge<0>, pg8::StaticOrder, true, true>(ldsl, g, S, E, wave); }
        { pg8::Gemm g{OBG, Wbo, MP, 1024, 1024}; pg8::StaticOrder S; S.init(MP, 1024, G, bx); epi::EpiMerge<1> E{GB, MG}; epi::light_gemm(OBG, Wbo, 1024, 1024, E, wave, bx, G, ldsl);
          pg8::gemm_phase<epi::EpiMerge<1>, pg8::StaticOrder, true, true>(ldsl, g, S, E, wave); }
    }
    SEAM(3);
    for (int rep = 0; rep < NREP(4); ++rep) if (IN(4)) {
        pg8::Gemm g{MG, Wo, MP, 1024, 1024}; pg8::StaticOrder S; S.init(MP, 1024, G, bx); epi::EpiResX E{x_p, x_s, ZB}; epi::light_gemm(MG, Wo, 1024, 1024, E, wave, bx, G, ldsl);
        pg8::gemm_phase<epi::EpiResX, pg8::StaticOrder, true, true>(ldsl, g, S, E, wave);
    }
    SEAM(4);
    for (int rep = 0; rep < NREP(5); ++rep) if (IN(5)) ln_phase(ZB, XB, nullptr, ln1g, ln1b, gw, NGW, lane);
    SEAM(5);
#pragma unroll 1
    for (int half = 0; half < 2; ++half) {
        for (int rep = 0; rep < NREP(6); ++rep) if (IN(6 + 2 * half)) {
            pg8::Gemm g{XB, Wup + (size_t)half * DFF * 1024, MP, DFF, 1024}; pg8::StaticOrder S; S.init(MP, DFF, G, bx); epi::EpiUp E{UP, out, half}; epi::light_gemm_wide(XB, Wup + (size_t)half * DFF * 1024, DFF, 1024, E, wave, bx, G, ldsl);
            pg8::gemm_phase<epi::EpiUp, pg8::StaticOrder, true, true>(ldsl, g, S, E, wave);
        }
        SEAM(6 + 2 * half);
        for (int rep = 0; rep < NREP(7); ++rep) if (IN(7 + 2 * half)) conv_phase(UP, HB, conv_w, conv_b, cconv, half, gw, NGW, lane);
        SEAM(7 + 2 * half);
    }
    for (int rep = 0; rep < NREP(10); ++rep) if (IN(10)) {
        pg8::Gemm g{HB, Wdn, MP, 1024, DFF}; pg8::StaticOrder S; S.init(MP, 1024, G, bx); epi::EpiResB<0> E{XB, ZB, nullptr}; epi::light_gemm(HB, Wdn, 1024, DFF, E, wave, bx, G, ldsl);
        pg8::gemm_phase<epi::EpiResB<0>, pg8::StaticOrder, true, true>(ldsl, g, S, E, wave);
    }
    SEAM(10);
    for (int rep = 0; rep < NREP(5); ++rep) if (IN(11)) ln_phase(ZB, XB, nullptr, ln2g, ln2b, gw, NGW, lane);
    SEAM(11);
    for (int rep = 0; rep < NREP(12); ++rep) if (IN(12)) {
        { int kpl = 256; asm volatile("" : "+s"(kpl)); pg8::Gemm g{PB, Wpl, MP, 1024, kpl}; pg8::StaticOrder S; S.init(MP, 1024, G, bx); epi::EpiStore E{TMP}; epi::light_gemm(PB, Wpl, 1024, kpl, E, wave, bx, G, ldsl);
          pg8::gemm_phase<epi::EpiStore, pg8::StaticOrder, true, true>(ldsl, g, S, E, wave); }
        { pg8::Gemm g{XB, Wplg, MP, 1024, 1024}; pg8::StaticOrder S; S.init(MP, 1024, G, bx); epi::EpiResB<1> E{XB, ZB, TMP}; epi::light_gemm(XB, Wplg, 1024, 1024, E, wave, bx, G, ldsl);
          pg8::gemm_phase<epi::EpiResB<1>, pg8::StaticOrder, true, true>(ldsl, g, S, E, wave); }
    }
    SEAM(12);
    for (int rep = 0; rep < NREP(5); ++rep) if (IN(13)) ln_phase(ZB, nullptr, Y, ln3g, ln3b, gw, NGW, lane);
#undef IN
#undef SEAM
}
#undef out
#undef lane
#undef tid
#undef ws
#undef Y
#undef GA
#undef A1
#undef S0

extern "C" void kernel_launch(void* const* d_in, const int* in_sizes, int n_in, void* d_out, int out_size, void* d_ws, size_t ws_size, hipStream_t stream) {
    static int grid = 0;
    if (grid == 0) {
        int dev = 0, cus = 0;
        if (hipGetDevice(&dev) != hipSuccess || hipDeviceGetAttribute(&cus, hipDeviceAttributeMultiprocessorCount, dev) != hipSuccess) { grid = -1; return; }
        if (hipFuncSetAttribute((const void*)fwd_kernel, hipFuncAttributeMaxDynamicSharedMemorySize, LDS_BYTES) != hipSuccess) { fprintf(stderr, "kernel_launch: hipFuncSetAttribute failed\n"); grid = -1; return; }
        int per_cu = 0;
        if (hipOccupancyMaxActiveBlocksPerMultiprocessor(&per_cu, (const void*)fwd_kernel, 512, LDS_BYTES) != hipSuccess || per_cu < 1) { fprintf(stderr, "kernel_launch: occupancy query says %d\n", per_cu); per_cu = 1; }
        (void)hipGetLastError();
        grid = cus;
        if (n_in != 29 || ws_size < (size_t)1000 * MiB) fprintf(stderr, "kernel_launch: unexpected n_in %d / ws %zu\n", n_in, ws_size);
    }
    if (grid < 0) return;
    (void)hipMemsetAsync((char*)d_ws + WS_CTL, 0, 65536, stream);
    Args a{};
    for (int i = 0; i < 29; ++i) a.in[i] = (const float*)d_in[i];
    a.out = (float*)d_out; a.ws = (unsigned char*)d_ws;
#if ONE_LAUNCH
    a.ph_lo = 0; a.ph_hi = N_PHASES;
    void* kargs[] = {&a};
    hipError_t e = hipLaunchCooperativeKernel((const void*)fwd_kernel, dim3(grid), dim3(512), kargs, LDS_BYTES, stream);
    if (e != hipSuccess) fprintf(stderr, "cooperative launch failed: %s (grid %d)\n", hipGetErrorString(e), grid);
#else
    for (int p = 0; p < N_PHASES; ++p) { a.ph_lo = p; a.ph_hi = p + 1; hipLaunchKernelGGL(fwd_kernel, dim3(grid), dim3(512), LDS_BYTES, stream, a); }
#endif
}
```
